# Optimizing an MI355X kernel written in HIP

```python
import jax, jax.numpy as jnp
from jax import lax
import numpy as np

D_MODEL = 1024
BATCH = 16
SEQ = 4096
DEPTH = 1
DEC_BATCH = 4
DEC_SEQ = 8192
PAST_LEN = 128

HEAD_DIM = 64
HEADS_PER_GROUP = 8
ATTN_PATTERNS = ((128, 1), (512, 4), (2048, 16))
N_GROUPS = len(ATTN_PATTERNS)
N_ATTN_HEADS = N_GROUPS * HEADS_PER_GROUP
ATTN_WIDTH = N_ATTN_HEADS * HEAD_DIM
ATTN_OUT = HEADS_PER_GROUP * HEAD_DIM
SGU_WIDTH = D_MODEL
CHUNK = 128
SGU_GROUPS = 8
SGU_GROUP_DIM = SGU_WIDTH // SGU_GROUPS
D_FF = 4 * D_MODEL
IN_COLS = 3 * ATTN_WIDTH + 2 * SGU_WIDTH + 2 * D_MODEL
EPS = 1e-6
MASK_VALUE = -1e30

kernel_name = "gated_dilated_attn_sgu_encoder"


def rms_norm(x, g):
    xf = x.astype(jnp.float32)
    y = xf * lax.rsqrt(jnp.mean(xf * xf, axis=-1, keepdims=True) + EPS)
    return (y * g.astype(jnp.float32)).astype(x.dtype)


def alibi_slopes(n):
    return jnp.asarray(2.0 ** (-8.0 * np.arange(1, n + 1) / n), dtype=jnp.float32)


def dilated_window_attention(q, k, v, window, dilation, slopes):
    B, S, H, hd = q.shape
    d = dilation
    n = window // (2 * d)
    L = S // d
    nb = -(-L // n)
    Lp = nb * n

    def by_residue(t):
        return t.reshape(B, L, d, H, hd).transpose(0, 2, 1, 3, 4)

    qr, kr, vr = by_residue(q), by_residue(k), by_residue(v)
    qb = jnp.pad(qr, ((0, 0), (0, 0), (0, Lp - L), (0, 0), (0, 0))).reshape(B, d, nb, n, H, hd)
    kv_pad = ((0, 0), (0, 0), (n, Lp - L + n), (0, 0), (0, 0))

    def band(t):
        tb = jnp.pad(t, kv_pad).reshape(B, d, nb + 2, n, H, hd)
        return jnp.concatenate([tb[:, :, :nb], tb[:, :, 1:nb + 1], tb[:, :, 2:]], axis=3)

    kb, vb = band(kr), band(vr)
    s = jnp.einsum('bciqhe,bcikhe->bcihqk', qb, kb,
                   preferred_element_type=jnp.float32) * (hd ** -0.5)
    rel = jnp.arange(3 * n)[None, :] - n - jnp.arange(n)[:, None]
    m_k = jnp.arange(nb)[:, None] * n + jnp.arange(3 * n)[None, :] - n
    valid = (jnp.abs(rel) <= n)[None] & ((m_k >= 0) & (m_k < L))[:, None, :]
    dist = (d * jnp.abs(rel)).astype(jnp.float32)
    s = s - slopes[:, None, None] * dist[None]
    s = jnp.where(valid[None, None, :, None], s, MASK_VALUE)
    row_max = jnp.max(s, axis=-1)
    p = jnp.exp(s - row_max[..., None])
    denom = jnp.sum(p, axis=-1)
    o = jnp.einsum('bcihqk,bcikhe->bciqhe', p, vb.astype(jnp.float32))
    o = o / jnp.swapaxes(denom, -1, -2)[..., None]

    def from_residue(t):
        t = t.reshape((B, d, Lp) + t.shape[4:])[:, :, :L]
        t = jnp.moveaxis(t, 1, 2)
        return t.reshape((B, S) + t.shape[3:])

    return (from_residue(o),
            from_residue(jnp.swapaxes(row_max, -1, -2)),
            from_residue(jnp.swapaxes(denom, -1, -2)))


def attention_mixer(q, k, v):
    slopes = alibi_slopes(N_ATTN_HEADS).reshape(N_GROUPS, HEADS_PER_GROUP)
    outs, maxs, dens = [], [], []
    for g, (window, dilation) in enumerate(ATTN_PATTERNS):
        o, mx, dn = dilated_window_attention(q[:, :, g], k[:, :, g], v[:, :, g], window, dilation, slopes[g])
        outs.append(o); maxs.append(mx); dens.append(dn)
    outs = jnp.stack(outs)
    maxs = jnp.stack(maxs)
    dens = jnp.stack(dens)
    w = dens * jnp.exp(maxs - jnp.max(maxs, axis=0, keepdims=True))
    return jnp.sum(w[..., None] * outs, axis=0) / jnp.sum(w, axis=0)[..., None]


def spatial_gating(u, v, w_s, b_s, g_sgu):
    B, S, _ = u.shape
    v = rms_norm(v, g_sgu)
    vc = v.reshape(B, S // CHUNK, CHUNK, SGU_GROUPS, SGU_GROUP_DIM)
    mixed = jnp.einsum('gts,bcsge->bctge', w_s, vc) + b_s.T[None, None, :, :, None]
    return u * mixed.reshape(B, S, SGU_WIDTH)


def encoder_layer(x, g_mix, w_in, w_s, b_s, g_sgu, w_branch_a, w_branch_b, w_out, g_mlp, w_up, w_down):
    B, S, _ = x.shape
    h = rms_norm(x, g_mix)
    proj = h @ w_in
    cuts = np.cumsum([ATTN_WIDTH, ATTN_WIDTH, ATTN_WIDTH, 2 * SGU_WIDTH, D_MODEL]).tolist()
    q, k, v, z, ga, gb = jnp.split(proj, cuts, axis=-1)
    hshape = (B, S, N_GROUPS, HEADS_PER_GROUP, HEAD_DIM)
    attn = attention_mixer(q.reshape(hshape), k.reshape(hshape), v.reshape(hshape))
    attn = attn.reshape(B, S, ATTN_OUT).astype(x.dtype)
    z = jax.nn.gelu(z, approximate=False)
    u, vs = jnp.split(z, 2, axis=-1)
    sgu = spatial_gating(u, vs, w_s, b_s, g_sgu)
    merged = jax.nn.sigmoid(ga) * (attn @ w_branch_a) + jax.nn.sigmoid(gb) * (sgu @ w_branch_b)
    x = x + merged @ w_out
    h2 = rms_norm(x, g_mlp)
    x = x + jnp.square(jax.nn.relu(h2 @ w_up)) @ w_down
    return x


def encoder_forward(x, g_mix, w_in, w_s, b_s, g_sgu, w_branch_a, w_branch_b, w_out, g_mlp, w_up, w_down, g_final):
    for l in range(DEPTH):
        x = encoder_layer(x, g_mix[l], w_in[l], w_s[l], b_s[l], g_sgu[l], w_branch_a[l], w_branch_b[l],
                          w_out[l], g_mlp[l], w_up[l], w_down[l])
    return rms_norm(x, g_final)


def setup_inputs(seed: int = 0) -> dict:
    key = jax.random.key(seed)
    ks = jax.random.split(key, 16)
    f32 = jnp.float32

    def normal(k, shape, scale):
        return jax.random.normal(k, shape, f32) * scale

    return {
        "x_prompt": normal(ks[0], (BATCH, SEQ, D_MODEL), 1.0),
        "x_sample": normal(ks[1], (DEC_BATCH, DEC_SEQ, D_MODEL), 1.0),
        "g_mix": 1.0 + normal(ks[2], (DEPTH, D_MODEL), 0.02),
        "w_in": normal(ks[3], (DEPTH, D_MODEL, IN_COLS), D_MODEL ** -0.5),
        "w_s": normal(ks[4], (DEPTH, SGU_GROUPS, CHUNK, CHUNK), CHUNK ** -0.5),
        "b_s": 1.0 + normal(ks[5], (DEPTH, SGU_GROUPS, CHUNK), 0.02),
        "g_sgu": 1.0 + normal(ks[6], (DEPTH, SGU_WIDTH), 0.02),
        "w_branch_a": normal(ks[7], (DEPTH, ATTN_OUT, D_MODEL), ATTN_OUT ** -0.5),
        "w_branch_b": normal(ks[8], (DEPTH, SGU_WIDTH, D_MODEL), SGU_WIDTH ** -0.5),
        "w_out": normal(ks[9], (DEPTH, D_MODEL, D_MODEL), D_MODEL ** -0.5),
        "g_mlp": 1.0 + normal(ks[10], (DEPTH, D_MODEL), 0.02),
        "w_up": normal(ks[11], (DEPTH, D_MODEL, D_FF), D_MODEL ** -0.5),
        "w_down": normal(ks[12], (DEPTH, D_FF, D_MODEL), D_FF ** -0.5),
        "g_final": 1.0 + normal(ks[13], (D_MODEL,), 0.02),
    }


def reference(x_prompt, x_sample, g_mix, w_in, w_s, b_s, g_sgu, w_branch_a, w_branch_b, w_out,
              g_mlp, w_up, w_down, g_final):
    y_prompt = encoder_forward(x_prompt, g_mix, w_in, w_s, b_s, g_sgu, w_branch_a, w_branch_b, w_out,
                               g_mlp, w_up, w_down, g_final)
    y_sample = encoder_forward(x_sample, g_mix, w_in, w_s, b_s, g_sgu, w_branch_a, w_branch_b, w_out,
                               g_mlp, w_up, w_down, g_final)
    return (y_prompt, y_sample)
```

```cpp
#include <hip/hip_runtime.h>
#include <hip/hip_cooperative_groups.h>
#include <cstdio>
#include <cstdint>
namespace cg = cooperative_groups;

#define LAS __attribute__((address_space(3)))
typedef unsigned short bf16_t;
typedef short bf16x8 __attribute__((ext_vector_type(8)));
typedef short s16x4 __attribute__((ext_vector_type(4)));
typedef float f32x4 __attribute__((ext_vector_type(4)));
typedef float f32x2 __attribute__((ext_vector_type(2)));
typedef unsigned u32x4 __attribute__((ext_vector_type(4)));
typedef unsigned u32x2 __attribute__((ext_vector_type(2)));

constexpr int DM = 1024, MC = 32768, NCHUNK = 3, M_ALL = MC * NCHUNK;
constexpr int IN_COLS = 8704, QKV_W = 4608, UV_W = 2048, GG_W = 2048, FF = 4096, AO = 512;
constexpr float EPS = 1e-6f;
constexpr float LOG2E = 1.4426950408889634f;

constexpr size_t MiB = 1u << 20;
constexpr size_t WS_CTL = 0, CTL_BYTES = 1536 * 1024;
constexpr size_t WS_BAR = 1536 * 1024, BAR_BYTES = 16384;
constexpr int LDS_MISC_OFF = 131072 + 512;
constexpr size_t OFF_RSQV = 0, OFF_RSQ1 = 512 * 1024, OFF_RSQ2 = 1024 * 1024, OFF_PCNT = 1408 * 1024;
constexpr size_t WS_RSX = 2 * MiB;
constexpr size_t WS_WIN = 4 * MiB, WS_WA = 22 * MiB, WS_WB = 24 * MiB, WS_WO = 26 * MiB, WS_WUP = 28 * MiB, WS_WDN = 36 * MiB;
constexpr size_t WS_H = 48 * MiB;
constexpr size_t WS_QKV = 112 * MiB;
constexpr size_t WS_UV = 400 * MiB;
constexpr size_t WS_GG = 528 * MiB;
constexpr size_t WS_PO = 656 * MiB;
constexpr size_t WS_PS = 720 * MiB;
constexpr size_t WS_ATTN = 724 * MiB;
constexpr size_t WS_SGU = 788 * MiB;
constexpr size_t WS_END = 852 * MiB;
constexpr size_t WS_T1 = WS_QKV;
constexpr size_t WS_MERGED = WS_QKV + 128 * MiB;
constexpr size_t WS_X1B = WS_QKV + 192 * MiB;
constexpr size_t WS_UP = WS_UV;

constexpr int LDS_BYTES = 147456;
#ifndef MK_MULTI
#define MK_MULTI 0
#endif
#ifndef EXP_SS
#define EXP_SS true
#endif
#ifndef EXP_GMODE
#define EXP_GMODE 2
#endif
#ifndef EXP_SKIP_MIX
#define EXP_SKIP_MIX 0
#endif

namespace pg8 {
constexpr int BM = 256, BK = 64, HALF = 128, HTB = HALF * BK * 2, STAGE_BYTES = 8 * HTB, NXCD = 8, WGM = 8;
__host__ __device__ __forceinline__ int lds_byte(int r, int c) { const int st = (r >> 4) * 2 + (c >> 5), rr = r & 15, cc = c & 31, ob = rr * 64 + cc * 2; return st * 1024 + (ob ^ (((ob >> 9) & 1) << 5)); }
__host__ __device__ __forceinline__ void stage_rc(int b, int& R, int& C) { const int st = b / 1024, sb = b % 1024, swz = sb ^ (((sb >> 9) & 1) << 5); R = (st >> 1) * 16 + swz / 64; C = (st & 1) * 32 + (swz % 64) / 2; }
__host__ __device__ __forceinline__ int perm32(int rho) { const int n = rho >> 4, i = rho & 15; return 8 * (i >> 2) + 4 * n + (i & 3); }

struct Unit { int pm, pn; };
struct Gemm { const bf16_t* A; const bf16_t* Bt; int M, N, K; };

struct StaticOrder {
    int nM, nN, nwg, G, c;
    __host__ __device__ void init(int M, int N, int G_, int c_) { nM = M / BM; nN = N / BM; nwg = nM * nN; G = G_; c = c_; }
    __host__ __device__ bool next(int i, Unit& u) const {
        const long L = (long)i * G + c; if (L >= nwg) return false;
        int wgid = (int)L; { const int q = nwg / NXCD, r = nwg % NXCD, xcd = wgid % NXCD, off = wgid / NXCD; wgid = (xcd < r ? xcd * (q + 1) : r * (q + 1) + (xcd - r) * q) + off; }
        const int nig = WGM * nN, gid = wgid / nig, fm = gid * WGM, gsz = (nM - fm) < WGM ? (nM - fm) : WGM;
        u.pm = fm + ((wgid % nig) % gsz); u.pn = (wgid % nig) / gsz; return true;
    }
    __device__ __forceinline__ void a_ready(const Unit&) const {}
    __device__ __forceinline__ void done(const Unit&) const {}
};

typedef __bf16 bf16x2_t __attribute__((ext_vector_type(2)));
__device__ __forceinline__ unsigned cvt_pk_bf16(float lo, float hi) { const bf16x2_t r = __builtin_convertvector((f32x2){lo, hi}, bf16x2_t); return __builtin_bit_cast(unsigned, r); }
__device__ __forceinline__ f32x2 gelu_pk(f32x2 v) {
    const f32x2 av = __builtin_elementwise_abs(v), d = av * 0.2316418882f + 1.0f;
    f32x2 t; t.x = __builtin_amdgcn_rcpf(d.x); t.y = __builtin_amdgcn_rcpf(d.y);
    f32x2 q = t * 0.5307027145f + (-0.7265760135f); q = q * t + 0.7107068705f; q = q * t + (-0.142248368f); q = q * t + 0.127414796f; q = q * t;
    const f32x2 s = (v * v) * (-0.72134752044f);
    f32x2 e; e.x = __builtin_amdgcn_exp2f(s.x); e.y = __builtin_amdgcn_exp2f(s.y);
    const f32x2 m = v * (q * e), r = v - m;
    f32x2 o; o.x = v.x < 0.f ? m.x : r.x; o.y = v.y < 0.f ? m.y : r.y; return o;
}
__device__ __forceinline__ f32x4 gelu4(f32x4 v) { f32x2 a = gelu_pk((f32x2){v[0], v[1]}), b = gelu_pk((f32x2){v[2], v[3]}); return (f32x4){a.x, a.y, b.x, b.y}; }
__device__ __forceinline__ float sigm(float x) { return __builtin_amdgcn_rcpf(1.0f + __builtin_amdgcn_exp2f(-x * LOG2E)); }
__device__ __forceinline__ f32x4 sigm4(f32x4 v) { return (f32x4){sigm(v[0]), sigm(v[1]), sigm(v[2]), sigm(v[3])}; }
__device__ __forceinline__ u32x4 pack8(f32x4 v0, f32x4 v1) { u32x4 w; w.x = cvt_pk_bf16(v0[0], v0[1]); w.y = cvt_pk_bf16(v0[2], v0[3]); w.z = cvt_pk_bf16(v1[0], v1[1]); w.w = cvt_pk_bf16(v1[2], v1[3]); return w; }
__device__ __forceinline__ float bf_lo(unsigned w) { return __uint_as_float(w << 16); }
__device__ __forceinline__ float bf_hi(unsigned w) { return __uint_as_float(w & 0xffff0000u); }
__device__ __forceinline__ float dot4(f32x4 v) { return (v[0] * v[0] + v[1] * v[1]) + (v[2] * v[2] + v[3] * v[3]); }

struct EpiProj {
    static constexpr bool PERM = true, AFTER_DRAIN = false;
    bf16_t* qkv; bf16_t* uv; bf16_t* gg; float* rowsq;
    template <int MODE, bool SS>
    __device__ __forceinline__ void tile(const f32x4 (&acc)[2][2][4][2], bf16_t* base, int ld, int row0, int col0) const {
#pragma unroll
        for (int ai = 0; ai < 2; ++ai)
#pragma unroll
            for (int m = 0; m < 4; ++m) { const int row = row0 + ai * HALF + m * 16; bf16_t* rowp = base + (size_t)row * ld + col0; float ss = 0.f;
#pragma unroll
                for (int bj = 0; bj < 2; ++bj) { f32x4 v0 = acc[ai][bj][m][0], v1 = acc[ai][bj][m][1];
                    if (MODE == 1) { v0 = gelu4(v0); v1 = gelu4(v1); }
                    if (MODE == 2) { v0 = sigm4(v0); v1 = sigm4(v1); }
                    if (SS) ss += dot4(v0) + dot4(v1);
                    *(u32x4*)(rowp + bj * HALF) = pack8(v0, v1); }
                if (SS) { ss += __shfl_xor(ss, 16); ss += __shfl_xor(ss, 32); if ((threadIdx.x & 48) == 0) unsafeAtomicAdd(rowsq + row, ss); }
                asm volatile("" ::: "memory"); }
    }
    __device__ __forceinline__ void operator()(const f32x4 (&acc)[2][2][4][2], const Unit& u, int wr, int wc, int fr, int fq) const {
        const int pn = u.pn, row0 = u.pm * BM + wr * 64 + fr, cw = wc * 32 + 8 * fq;
        if (pn < 18) tile<0, false>(acc, qkv, QKV_W, row0, pn * 256 + cw);
        else if (pn < 22) tile<1, false>(acc, uv, UV_W, row0, (pn - 18) * 256 + cw);
        else if (pn < 26) tile<1, EXP_SS>(acc, uv, UV_W, row0, (pn - 18) * 256 + cw);
        else tile<EXP_GMODE, false>(acc, gg, GG_W, row0, (pn - 26) * 256 + cw);
    }
};
struct EpiM1 {
    static constexpr bool PERM = true, AFTER_DRAIN = false;
    const bf16_t* gate; bf16_t* t1;
    __device__ __forceinline__ void operator()(const f32x4 (&acc)[2][2][4][2], const Unit& u, int wr, int wc, int fr, int fq) const {
        const int row0 = u.pm * BM + wr * 64 + fr, col0 = u.pn * BM + wc * 32 + 8 * fq;
#pragma unroll
        for (int ai = 0; ai < 2; ++ai)
#pragma unroll
            for (int m = 0; m < 4; ++m) { const size_t row = row0 + ai * HALF + m * 16;
#pragma unroll
                for (int bj = 0; bj < 2; ++bj) { const u32x4 gw = *(const u32x4*)(gate + row * GG_W + col0 + bj * HALF);
                    f32x4 v0 = acc[ai][bj][m][0], v1 = acc[ai][bj][m][1];
                    v0 = v0 * (f32x4){bf_lo(gw.x), bf_hi(gw.x), bf_lo(gw.y), bf_hi(gw.y)}; v1 = v1 * (f32x4){bf_lo(gw.z), bf_hi(gw.z), bf_lo(gw.w), bf_hi(gw.w)};
                    *(u32x4*)(t1 + row * DM + col0 + bj * HALF) = pack8(v0, v1); }
                if (m & 1) asm volatile("" ::: "memory"); }
    }
};
struct EpiM2 {
    static constexpr bool PERM = true, AFTER_DRAIN = false;
    const bf16_t* gate; const bf16_t* t1; bf16_t* merged;
    __device__ __forceinline__ void operator()(const f32x4 (&acc)[2][2][4][2], const Unit& u, int wr, int wc, int fr, int fq) const {
        const int row0 = u.pm * BM + wr * 64 + fr, col0 = u.pn * BM + wc * 32 + 8 * fq;
#pragma unroll
        for (int ai = 0; ai < 2; ++ai)
#pragma unroll
            for (int m = 0; m < 4; ++m) { const size_t row = row0 + ai * HALF + m * 16;
#pragma unroll
                for (int bj = 0; bj < 2; ++bj) { const u32x4 gw = *(const u32x4*)(gate + row * GG_W + col0 + bj * HALF);
                    const u32x4 tw = *(const u32x4*)(t1 + row * DM + col0 + bj * HALF); const f32x4 a0 = (f32x4){bf_lo(tw.x), bf_hi(tw.x), bf_lo(tw.y), bf_hi(tw.y)}, a1 = (f32x4){bf_lo(tw.z), bf_hi(tw.z), bf_lo(tw.w), bf_hi(tw.w)};
                    f32x4 v0 = acc[ai][bj][m][0], v1 = acc[ai][bj][m][1];
                    v0 = a0 + v0 * (f32x4){bf_lo(gw.x), bf_hi(gw.x), bf_lo(gw.y), bf_hi(gw.y)}; v1 = a1 + v1 * (f32x4){bf_lo(gw.z), bf_hi(gw.z), bf_lo(gw.w), bf_hi(gw.w)};
                    *(u32x4*)(merged + row * DM + col0 + bj * HALF) = pack8(v0, v1); }
                if (m & 1) asm volatile("" ::: "memory"); }
    }
};
struct EpiMid {
    const bf16_t* gg;
    __device__ __forceinline__ void operator()(f32x4 (&acc)[2][2][4][2], const Unit& u, int wr, int wc, int fr, int fq) const {
        const int row0 = u.pm * BM + wr * 64 + fr, col0 = u.pn * BM + wc * 32 + 8 * fq;
#pragma unroll
        for (int ai = 0; ai < 2; ++ai)
#pragma unroll
            for (int m = 0; m < 4; ++m) { const size_t row = row0 + ai * HALF + m * 16;
#pragma unroll
                for (int bj = 0; bj < 2; ++bj) { const u32x4 aw = *(const u32x4*)(gg + row * GG_W + col0 + bj * HALF), bw = *(const u32x4*)(gg + row * GG_W + 1024 + col0 + bj * HALF);
                    const f32x4 sa0 = (f32x4){bf_lo(aw.x), bf_hi(aw.x), bf_lo(aw.y), bf_hi(aw.y)}, sa1 = (f32x4){bf_lo(aw.z), bf_hi(aw.z), bf_lo(aw.w), bf_hi(aw.w)};
                    f32x4 sb0 = (f32x4){bf_lo(bw.x), bf_hi(bw.x), bf_lo(bw.y), bf_hi(bw.y)}, sb1 = (f32x4){bf_lo(bw.z), bf_hi(bw.z), bf_lo(bw.w), bf_hi(bw.w)};
                    const f32x4 tiny = (f32x4){1e-30f, 1e-30f, 1e-30f, 1e-30f};
                    sb0 = __builtin_elementwise_max(sb0, tiny); sb1 = __builtin_elementwise_max(sb1, tiny);
                    const f32x4 r0 = sa0 * (f32x4){__builtin_amdgcn_rcpf(sb0[0]), __builtin_amdgcn_rcpf(sb0[1]), __builtin_amdgcn_rcpf(sb0[2]), __builtin_amdgcn_rcpf(sb0[3])};
                    const f32x4 r1 = sa1 * (f32x4){__builtin_amdgcn_rcpf(sb1[0]), __builtin_amdgcn_rcpf(sb1[1]), __builtin_amdgcn_rcpf(sb1[2]), __builtin_amdgcn_rcpf(sb1[3])};
                    acc[ai][bj][m][0] *= r0; acc[ai][bj][m][1] *= r1; }
                if (m & 1) asm volatile("" ::: "memory"); }
    }
};
struct EpiMerge {
    const bf16_t* gg; bf16_t* merged;
    __device__ __forceinline__ void operator()(f32x4 (&acc)[2][2][4][2], const Unit& u, int wr, int wc, int fr, int fq) const {
        const int row0 = u.pm * BM + wr * 64 + fr, col0 = u.pn * BM + wc * 32 + 8 * fq;
#pragma unroll
        for (int ai = 0; ai < 2; ++ai)
#pragma unroll
            for (int m = 0; m < 4; ++m) { const size_t row = row0 + ai * HALF + m * 16;
#pragma unroll
                for (int bj = 0; bj < 2; ++bj) { const u32x4 bw = *(const u32x4*)(gg + row * GG_W + 1024 + col0 + bj * HALF);
                    const f32x4 v0 = acc[ai][bj][m][0] * (f32x4){bf_lo(bw.x), bf_hi(bw.x), bf_lo(bw.y), bf_hi(bw.y)}, v1 = acc[ai][bj][m][1] * (f32x4){bf_lo(bw.z), bf_hi(bw.z), bf_lo(bw.w), bf_hi(bw.w)};
                    *(u32x4*)(merged + row * DM + col0 + bj * HALF) = pack8(v0, v1); }
                if (m & 1) asm volatile("" ::: "memory"); }
    }
};
template <bool WB16> struct EpiRes {
    static constexpr bool PERM = true, AFTER_DRAIN = false;
    const bf16_t* hi; const float* rsx; float* xo; bf16_t* xb; float* rowsq;
    __device__ __forceinline__ void operator()(const f32x4 (&acc)[2][2][4][2], const Unit& u, int wr, int wc, int fr, int fq) const {
        const int row0 = u.pm * BM + wr * 64 + fr, col0 = u.pn * BM + wc * 32 + 8 * fq;
#pragma unroll
        for (int ai = 0; ai < 2; ++ai)
#pragma unroll
            for (int m = 0; m < 4; ++m) { const size_t row = row0 + ai * HALF + m * 16; float ss = 0.f; const float rx = rsx[row];
#pragma unroll
                for (int bj = 0; bj < 2; ++bj) { const size_t off = row * DM + col0 + bj * HALF;
                    const u32x4 hw = *(const u32x4*)(hi + off);
                    const f32x4 a0 = (f32x4){bf_lo(hw.x), bf_hi(hw.x), bf_lo(hw.y), bf_hi(hw.y)} * rx, a1 = (f32x4){bf_lo(hw.z), bf_hi(hw.z), bf_lo(hw.w), bf_hi(hw.w)} * rx;
                    const f32x4 v0 = a0 + acc[ai][bj][m][0], v1 = a1 + acc[ai][bj][m][1];
                    ss += dot4(v0) + dot4(v1);
                    if (!WB16) { *(f32x4*)(xo + off) = v0; *(f32x4*)(xo + off + 4) = v1; }
                    if (WB16) *(u32x4*)(xb + off) = pack8(v0, v1); }
                ss += __shfl_xor(ss, 16); ss += __shfl_xor(ss, 32); if ((threadIdx.x & 48) == 0) unsafeAtomicAdd(rowsq + row, ss);
                if (m & 1) asm volatile("" ::: "memory"); }
    }
};
struct EpiFinal {
    static constexpr bool PERM = true, AFTER_DRAIN = false;
    const bf16_t* xi; float* xo; float* rowsq; unsigned* cnt; const float* gfin;
    __device__ __forceinline__ void operator()(f32x4 (&acc)[2][2][4][2], const Unit& u, int wr, int wc, int fr, int fq) const {
        const int row0 = u.pm * BM + wr * 64 + fr, col0 = u.pn * BM + wc * 32 + 8 * fq;
#pragma unroll
        for (int ai = 0; ai < 2; ++ai)
#pragma unroll
            for (int m = 0; m < 4; ++m) { const size_t row = row0 + ai * HALF + m * 16; float ss = 0.f;
#pragma unroll
                for (int bj = 0; bj < 2; ++bj) { const size_t off = row * DM + col0 + bj * HALF;
                    const u32x4 xw = *(const u32x4*)(xi + off);
                    acc[ai][bj][m][0] += (f32x4){bf_lo(xw.x), bf_hi(xw.x), bf_lo(xw.y), bf_hi(xw.y)}; acc[ai][bj][m][1] += (f32x4){bf_lo(xw.z), bf_hi(xw.z), bf_lo(xw.w), bf_hi(xw.w)};
                    ss += dot4(acc[ai][bj][m][0]) + dot4(acc[ai][bj][m][1]); }
                ss += __shfl_xor(ss, 16); ss += __shfl_xor(ss, 32); if ((threadIdx.x & 48) == 0) unsafeAtomicAdd(rowsq + row, ss);
                if (m & 1) asm volatile("" ::: "memory"); }
        asm volatile("s_waitcnt vmcnt(0)" ::: "memory");
        unsigned* pc = cnt + 64 * u.pm;
        if ((threadIdx.x & 63) == 0) __hip_atomic_fetch_add(pc, 1u, __ATOMIC_RELAXED, __HIP_MEMORY_SCOPE_AGENT);
        { unsigned sp = 0;
          while ((unsigned)__builtin_amdgcn_readfirstlane(__hip_atomic_load(pc, __ATOMIC_RELAXED, __HIP_MEMORY_SCOPE_AGENT)) < 32u) { __builtin_amdgcn_s_sleep(1); if (++sp > (1u << 22)) break; } }
        f32x4 gv[2][2];
#pragma unroll
        for (int bj = 0; bj < 2; ++bj) { gv[bj][0] = *(const f32x4*)(gfin + col0 + bj * HALF); gv[bj][1] = *(const f32x4*)(gfin + col0 + bj * HALF + 4); }
#pragma unroll
        for (int ai = 0; ai < 2; ++ai)
#pragma unroll
            for (int m = 0; m < 4; ++m) { const size_t row = row0 + ai * HALF + m * 16;
                const float q = __hip_atomic_load(rowsq + row, __ATOMIC_RELAXED, __HIP_MEMORY_SCOPE_AGENT);
                const float rs = __builtin_amdgcn_rsqf(q * (1.0f / DM) + EPS);
#pragma unroll
                for (int bj = 0; bj < 2; ++bj) { const size_t off = row * DM + col0 + bj * HALF;
                    *(f32x4*)(xo + off) = acc[ai][bj][m][0] * rs * gv[bj][0]; *(f32x4*)(xo + off + 4) = acc[ai][bj][m][1] * rs * gv[bj][1]; }
                if (m & 1) asm volatile("" ::: "memory"); }
    }
};
struct EpiUp {
    static constexpr bool PERM = true, AFTER_DRAIN = false;
    const float* rowsq; bf16_t* up;
    __device__ __forceinline__ void operator()(const f32x4 (&acc)[2][2][4][2], const Unit& u, int wr, int wc, int fr, int fq) const {
        const int row0 = u.pm * BM + wr * 64 + fr, col0 = u.pn * BM + wc * 32 + 8 * fq;
        float rsv[2][4];
#pragma unroll
        for (int ai = 0; ai < 2; ++ai)
#pragma unroll
            for (int m = 0; m < 4; ++m) rsv[ai][m] = rowsq[row0 + ai * HALF + m * 16];
#pragma unroll
        for (int ai = 0; ai < 2; ++ai)
#pragma unroll
            for (int m = 0; m < 4; ++m) { const size_t row = row0 + ai * HALF + m * 16; const float rs = __builtin_amdgcn_rsqf(rsv[ai][m] * (1.0f / DM) + EPS);
#pragma unroll
                for (int bj = 0; bj < 2; ++bj) { f32x4 v0 = acc[ai][bj][m][0] * rs, v1 = acc[ai][bj][m][1] * rs;
                    v0 = __builtin_elementwise_max(v0, (f32x4){0.f, 0.f, 0.f, 0.f}); v1 = __builtin_elementwise_max(v1, (f32x4){0.f, 0.f, 0.f, 0.f});
                    v0 = v0 * v0; v1 = v1 * v1;
                    *(u32x4*)(up + row * FF + col0 + bj * HALF) = pack8(v0, v1); }
                asm volatile("" ::: "memory"); }
    }
};

template <class Epi, class Sched, bool ALIGN_EPI = false, bool SP2 = false>
__device__ __forceinline__ void gemm_phase(LAS unsigned char* lds, const Gemm g, const Sched& S, const Epi& E) {
    int tid_ = threadIdx.x; asm volatile("" : "+v"(tid_));
    const int tid = tid_, wid = __builtin_amdgcn_readfirstlane(tid >> 6), lane = tid & 63, wr = wid >> 2, wc = wid & 3, fr = lane & 15, fq = lane >> 4;
    const int K = g.K, nt = K / BK;
    unsigned voffA[2], voffB[2];
#pragma unroll
    for (int i = 0; i < 2; ++i) { int R, C; stage_rc(tid * 16 + i * 8192, R, C); const int Rb = Epi::PERM ? ((R & ~31) + perm32(R & 31)) : R;
        voffA[i] = (unsigned)(R * K + C) * 2u; voffB[i] = (unsigned)(Rb * K + C) * 2u; }
    const size_t kstep = (size_t)(BK * 2);
    const size_t hstep = (size_t)HALF * K * 2;
    const size_t tstep = 2 * hstep;
    const unsigned ldsw = (unsigned)wid * 1024u;
    const int aoff = lds_byte(wr * 64 + fr, fq * 8), boff = lds_byte(wc * 32 + fr, fq * 8);
#define PG8_SA(b, h) (((b) * 2 + (h)) * HTB)
#define PG8_SB(b, h) ((4 + (b) * 2 + (h)) * HTB)
#define PG8_STAGE(bufoff, gbase, voff) do { _Pragma("unroll") for (int _i = 0; _i < 2; ++_i) \
        __builtin_amdgcn_global_load_lds((const unsigned*)((const char*)(gbase) + (voff)[_i]), (LAS unsigned*)(lds + (bufoff) + ldsw + _i * 8192), 16, 0, 0); } while (0)
#define PG8_LDA(dst, b, h) do { _Pragma("unroll") for (int m = 0; m < 4; ++m) _Pragma("unroll") for (int k = 0; k < 2; ++k) dst[m][k] = *(const LAS bf16x8*)(lds + PG8_SA(b, h) + aoff + m * 2048 + k * 1024); } while (0)
#define PG8_LDB(dst, b, h) do { _Pragma("unroll") for (int n = 0; n < 2; ++n) _Pragma("unroll") for (int k = 0; k < 2; ++k) dst[n][k] = *(const LAS bf16x8*)(lds + PG8_SB(b, h) + boff + n * 2048 + k * 1024); } while (0)
#define PG8_MMA(ai, bj, At, Bt) do { __builtin_amdgcn_s_setprio(1); _Pragma("unroll") for (int m = 0; m < 4; ++m) _Pragma("unroll") for (int n = 0; n < 2; ++n) _Pragma("unroll") for (int k = 0; k < 2; ++k) \
        acc[ai][bj][m][n] = __builtin_amdgcn_mfma_f32_16x16x32_bf16(Bt[n][k], At[m][k], acc[ai][bj][m][n], 0, 0, 0); __builtin_amdgcn_s_setprio(0); } while (0)
#define PG8_WAIT_V(n) asm volatile("s_waitcnt vmcnt(" #n ")" ::: "memory")
#define PG8_WAIT_L(n) asm volatile("s_waitcnt lgkmcnt(" #n ")" ::: "memory")
#define PG8_BAR __builtin_amdgcn_s_barrier()
#define PG8_SCHED __builtin_amdgcn_sched_barrier(0)
    Unit cur, nxt; int ui = 0;
    if (!S.next(0, cur)) return;
    f32x4 acc[2][2][4][2];
#pragma unroll
    for (int a = 0; a < 2; ++a)
#pragma unroll
        for (int b = 0; b < 2; ++b)
#pragma unroll
            for (int m = 0; m < 4; ++m)
#pragma unroll
                for (int n = 0; n < 2; ++n) acc[a][b][m][n] = (f32x4){0.f, 0.f, 0.f, 0.f};
    bf16x8 At[4][2], B0[2][2], B1[2][2];
    const char* cA = (const char*)g.A + (size_t)cur.pm * tstep; const char* cB = (const char*)g.Bt + (size_t)cur.pn * tstep;
    S.a_ready(cur);
    if constexpr (SP2) {
        PG8_STAGE(PG8_SB(0, 0), cB, voffB); PG8_STAGE(PG8_SB(0, 1), cB + hstep, voffB); PG8_STAGE(PG8_SA(0, 0), cA, voffA); PG8_STAGE(PG8_SA(0, 1), cA + hstep, voffA);
        if (wr == 1) PG8_BAR;
        PG8_WAIT_V(2); PG8_BAR;
        PG8_STAGE(PG8_SB(1, 0), cB + kstep, voffB); PG8_STAGE(PG8_SA(1, 0), cA + kstep, voffA); PG8_STAGE(PG8_SB(1, 1), cB + hstep + kstep, voffB);
        PG8_WAIT_V(6); PG8_BAR;
    } else {
        PG8_STAGE(PG8_SB(0, 0), cB, voffB); PG8_STAGE(PG8_SA(0, 0), cA, voffA); PG8_STAGE(PG8_SB(0, 1), cB + hstep, voffB); PG8_STAGE(PG8_SA(0, 1), cA + hstep, voffA);
        if (wr == 1) PG8_BAR;
        PG8_WAIT_V(4); PG8_BAR;
        PG8_STAGE(PG8_SB(1, 0), cB + kstep, voffB); PG8_STAGE(PG8_SA(1, 0), cA + kstep, voffA); PG8_STAGE(PG8_SB(1, 1), cB + hstep + kstep, voffB);
        PG8_WAIT_V(6); PG8_BAR;
    }
    for (;;) {
        const bool has_next = S.next(ui + 1, nxt);
        const char* nA = has_next ? (const char*)g.A + (size_t)nxt.pm * tstep : cA; const char* nB = has_next ? (const char*)g.Bt + (size_t)nxt.pn * tstep : cB;
        for (int t = 0; t < nt; t += 2) {
            const bool last = (t == nt - 2);
            const char* a1 = cA + (size_t)(t + 1) * kstep;
            const char* a2 = last ? nA : cA + (size_t)(t + 2) * kstep; const char* b2 = last ? nB : cB + (size_t)(t + 2) * kstep;
            const char* a3 = a2 + kstep; const char* b3 = b2 + kstep;
            if (last && has_next) S.a_ready(nxt);
            if constexpr (SP2) {
            PG8_LDB(B0, 0, 0); PG8_LDB(B1, 0, 1); PG8_SCHED; PG8_LDA(At, 0, 0); PG8_STAGE(PG8_SA(1, 1), a1 + hstep, voffA);
            PG8_WAIT_V(8); PG8_WAIT_L(0); PG8_BAR; PG8_MMA(0, 0, At, B0); PG8_MMA(0, 1, At, B1); PG8_BAR; PG8_SCHED;
            PG8_LDA(At, 0, 1); PG8_STAGE(PG8_SB(0, 0), b2, voffB); PG8_STAGE(PG8_SB(0, 1), b2 + hstep, voffB); PG8_STAGE(PG8_SA(0, 0), a2, voffA);
            PG8_WAIT_V(8); PG8_WAIT_L(0); PG8_BAR; PG8_MMA(1, 0, At, B0); PG8_MMA(1, 1, At, B1); PG8_BAR; PG8_SCHED;
            PG8_LDB(B0, 1, 0); PG8_LDB(B1, 1, 1); PG8_SCHED; PG8_LDA(At, 1, 0); PG8_STAGE(PG8_SA(0, 1), a2 + hstep, voffA);
            PG8_WAIT_V(8); PG8_WAIT_L(0); PG8_BAR; PG8_MMA(0, 0, At, B0); PG8_MMA(0, 1, At, B1); PG8_BAR; PG8_SCHED;
            PG8_LDA(At, 1, 1); PG8_STAGE(PG8_SB(1, 0), b3, voffB); PG8_STAGE(PG8_SB(1, 1), b3 + hstep, voffB); PG8_STAGE(PG8_SA(1, 0), a3, voffA);
            PG8_WAIT_V(8); PG8_WAIT_L(0); PG8_BAR; PG8_MMA(1, 0, At, B0); PG8_MMA(1, 1, At, B1); PG8_BAR; PG8_SCHED;
            } else {
            PG8_LDB(B0, 0, 0); PG8_SCHED; PG8_LDA(At, 0, 0); PG8_STAGE(PG8_SA(1, 1), a1 + hstep, voffA);
            PG8_WAIT_L(8); PG8_BAR; PG8_WAIT_L(0); PG8_MMA(0, 0, At, B0); PG8_BAR; PG8_SCHED;
            PG8_LDB(B1, 0, 1); PG8_STAGE(PG8_SB(0, 0), b2, voffB);
            PG8_BAR; PG8_WAIT_L(0); PG8_MMA(0, 1, At, B1); PG8_BAR;
            PG8_LDA(At, 0, 1); PG8_STAGE(PG8_SA(0, 0), a2, voffA);
            PG8_BAR; PG8_WAIT_L(0); PG8_MMA(1, 0, At, B0); PG8_BAR; PG8_SCHED;
            PG8_STAGE(PG8_SB(0, 1), b2 + hstep, voffB);
            PG8_WAIT_V(6); PG8_BAR; PG8_MMA(1, 1, At, B1); PG8_BAR;
            PG8_LDB(B0, 1, 0); PG8_SCHED; PG8_LDA(At, 1, 0); PG8_STAGE(PG8_SA(0, 1), a2 + hstep, voffA);
            PG8_WAIT_L(8); PG8_BAR; PG8_WAIT_L(0); PG8_MMA(0, 0, At, B0); PG8_BAR; PG8_SCHED;
            PG8_LDB(B1, 1, 1); PG8_STAGE(PG8_SB(1, 0), b3, voffB);
            PG8_BAR; PG8_WAIT_L(0); PG8_MMA(0, 1, At, B1); PG8_BAR;
            PG8_LDA(At, 1, 1); PG8_STAGE(PG8_SA(1, 0), a3, voffA);
            PG8_BAR; PG8_WAIT_L(0); PG8_MMA(1, 0, At, B0); PG8_BAR; PG8_SCHED;
            PG8_STAGE(PG8_SB(1, 1), b3 + hstep, voffB);
            PG8_WAIT_V(6); PG8_BAR; PG8_MMA(1, 1, At, B1); PG8_BAR;
            }
        }
        if constexpr (ALIGN_EPI) { if (wr == 0) PG8_BAR; }
        if constexpr (!Epi::AFTER_DRAIN) { E(acc, cur, wr, wc, fr, fq); S.done(cur); }
        if (!has_next) break;
#pragma unroll
        for (int a = 0; a < 2; ++a)
#pragma unroll
            for (int b = 0; b < 2; ++b)
#pragma unroll
                for (int m = 0; m < 4; ++m)
#pragma unroll
                    for (int n = 0; n < 2; ++n) acc[a][b][m][n] = (f32x4){0.f, 0.f, 0.f, 0.f};
        cur = nxt; cA = nA; cB = nB; ++ui;
        if constexpr (ALIGN_EPI) { if (wr == 1) PG8_BAR; }
    }
    PG8_WAIT_V(0);
    if constexpr (!ALIGN_EPI) { if (wr == 0) PG8_BAR; }
    PG8_BAR;
#undef PG8_SA
#undef PG8_SB
#undef PG8_STAGE
#undef PG8_LDA
#undef PG8_LDB
#undef PG8_MMA
#undef PG8_WAIT_V
#undef PG8_WAIT_L
#undef PG8_BAR
#undef PG8_SCHED
}

template <class Mid, class Epi, class Sched>
__device__ __forceinline__ void gemm_phase_dual(LAS unsigned char* lds, const bf16_t* A1, const bf16_t* B1, int nt1, const bf16_t* A2, const bf16_t* B2, int nt2, int ld, const Sched& S, const Mid& Mh, const Epi& E) {
    int tid_ = threadIdx.x; asm volatile("" : "+v"(tid_));
    const int tid = tid_, wid = __builtin_amdgcn_readfirstlane(tid >> 6), lane = tid & 63, wr = wid >> 2, wc = wid & 3, fr = lane & 15, fq = lane >> 4;
    unsigned voffA[2], voffB[2];
#pragma unroll
    for (int i = 0; i < 2; ++i) { int R, C; stage_rc(tid * 16 + i * 8192, R, C); const int Rb = ((R & ~31) + perm32(R & 31));
        voffA[i] = (unsigned)(R * ld + C) * 2u; voffB[i] = (unsigned)(Rb * ld + C) * 2u; }
    const size_t kstep = (size_t)(BK * 2);
    const size_t hstep = (size_t)HALF * ld * 2;
    const size_t tstep = 2 * hstep;
    const unsigned ldsw = (unsigned)wid * 1024u;
    const int aoff = lds_byte(wr * 64 + fr, fq * 8), boff = lds_byte(wc * 32 + fr, fq * 8);
#define PG8_SA(b, h) (((b) * 2 + (h)) * HTB)
#define PG8_SB(b, h) ((4 + (b) * 2 + (h)) * HTB)
#define PG8_STAGE(bufoff, gbase, voff) do { _Pragma("unroll") for (int _i = 0; _i < 2; ++_i) \
        __builtin_amdgcn_global_load_lds((const unsigned*)((const char*)(gbase) + (voff)[_i]), (LAS unsigned*)(lds + (bufoff) + ldsw + _i * 8192), 16, 0, 0); } while (0)
#define PG8_LDA(dst, b, h) do { _Pragma("unroll") for (int m = 0; m < 4; ++m) _Pragma("unroll") for (int k = 0; k < 2; ++k) dst[m][k] = *(const LAS bf16x8*)(lds + PG8_SA(b, h) + aoff + m * 2048 + k * 1024); } while (0)
#define PG8_LDB(dst, b, h) do { _Pragma("unroll") for (int n = 0; n < 2; ++n) _Pragma("unroll") for (int k = 0; k < 2; ++k) dst[n][k] = *(const LAS bf16x8*)(lds + PG8_SB(b, h) + boff + n * 2048 + k * 1024); } while (0)
#define PG8_MMA(ai, bj, At, Bt) do { __builtin_amdgcn_s_setprio(1); _Pragma("unroll") for (int m = 0; m < 4; ++m) _Pragma("unroll") for (int n = 0; n < 2; ++n) _Pragma("unroll") for (int k = 0; k < 2; ++k) \
        acc[ai][bj][m][n] = __builtin_amdgcn_mfma_f32_16x16x32_bf16(Bt[n][k], At[m][k], acc[ai][bj][m][n], 0, 0, 0); __builtin_amdgcn_s_setprio(0); } while (0)
#define PG8_WAIT_V(n) asm volatile("s_waitcnt vmcnt(" #n ")" ::: "memory")
#define PG8_WAIT_L(n) asm volatile("s_waitcnt lgkmcnt(" #n ")" ::: "memory")
#define PG8_BAR __builtin_amdgcn_s_barrier()
#define PG8_SCHED __builtin_amdgcn_sched_barrier(0)
    Unit cur, nxt; int ui = 0, seg = 0;
    if (!S.next(0, cur)) return;
    f32x4 acc[2][2][4][2];
#pragma unroll
    for (int a = 0; a < 2; ++a)
#pragma unroll
        for (int b = 0; b < 2; ++b)
#pragma unroll
            for (int m = 0; m < 4; ++m)
#pragma unroll
                for (int n = 0; n < 2; ++n) acc[a][b][m][n] = (f32x4){0.f, 0.f, 0.f, 0.f};
    bf16x8 At[4][2], B0[2][2], B1f[2][2];
    const char* cA = (const char*)A1 + (size_t)cur.pm * tstep; const char* cB = (const char*)B1 + (size_t)cur.pn * tstep; int nt = nt1;
    PG8_STAGE(PG8_SB(0, 0), cB, voffB); PG8_STAGE(PG8_SB(0, 1), cB + hstep, voffB); PG8_STAGE(PG8_SA(0, 0), cA, voffA); PG8_STAGE(PG8_SA(0, 1), cA + hstep, voffA);
    if (wr == 1) PG8_BAR;
    PG8_WAIT_V(2); PG8_BAR;
    PG8_STAGE(PG8_SB(1, 0), cB + kstep, voffB); PG8_STAGE(PG8_SA(1, 0), cA + kstep, voffA); PG8_STAGE(PG8_SB(1, 1), cB + hstep + kstep, voffB);
    PG8_WAIT_V(6); PG8_BAR;
    for (;;) {
        bool has_next; const char* nA; const char* nB; int nnt;
        if (seg == 0) { has_next = true; nA = (const char*)A2 + (size_t)cur.pm * tstep; nB = (const char*)B2 + (size_t)cur.pn * tstep; nnt = nt2; }
        else { has_next = S.next(ui + 1, nxt); nA = has_next ? (const char*)A1 + (size_t)nxt.pm * tstep : cA; nB = has_next ? (const char*)B1 + (size_t)nxt.pn * tstep : cB; nnt = nt1; }
        for (int t = 0; t < nt; t += 2) {
            const bool last = (t == nt - 2);
            const char* a1 = cA + (size_t)(t + 1) * kstep;
            const char* a2 = last ? nA : cA + (size_t)(t + 2) * kstep; const char* b2 = last ? nB : cB + (size_t)(t + 2) * kstep;
            const char* a3 = a2 + kstep; const char* b3 = b2 + kstep;
            PG8_LDB(B0, 0, 0); PG8_LDB(B1f, 0, 1); PG8_SCHED; PG8_LDA(At, 0, 0); PG8_STAGE(PG8_SA(1, 1), a1 + hstep, voffA);
            PG8_WAIT_V(8); PG8_WAIT_L(0); PG8_BAR; PG8_MMA(0, 0, At, B0); PG8_MMA(0, 1, At, B1f); PG8_BAR; PG8_SCHED;
            PG8_LDA(At, 0, 1); PG8_STAGE(PG8_SB(0, 0), b2, voffB); PG8_STAGE(PG8_SB(0, 1), b2 + hstep, voffB); PG8_STAGE(PG8_SA(0, 0), a2, voffA);
            PG8_WAIT_V(8); PG8_WAIT_L(0); PG8_BAR; PG8_MMA(1, 0, At, B0); PG8_MMA(1, 1, At, B1f); PG8_BAR; PG8_SCHED;
            PG8_LDB(B0, 1, 0); PG8_LDB(B1f, 1, 1); PG8_SCHED; PG8_LDA(At, 1, 0); PG8_STAGE(PG8_SA(0, 1), a2 + hstep, voffA);
            PG8_WAIT_V(8); PG8_WAIT_L(0); PG8_BAR; PG8_MMA(0, 0, At, B0); PG8_MMA(0, 1, At, B1f); PG8_BAR; PG8_SCHED;
            PG8_LDA(At, 1, 1); PG8_STAGE(PG8_SB(1, 0), b3, voffB); PG8_STAGE(PG8_SB(1, 1), b3 + hstep, voffB); PG8_STAGE(PG8_SA(1, 0), a3, voffA);
            PG8_WAIT_V(8); PG8_WAIT_L(0); PG8_BAR; PG8_MMA(1, 0, At, B0); PG8_MMA(1, 1, At, B1f); PG8_BAR; PG8_SCHED;
        }
        if (wr == 0) PG8_BAR;
        if (seg == 0) Mh(acc, cur, wr, wc, fr, fq); else E(acc, cur, wr, wc, fr, fq);
        if (seg == 1 && !has_next) break;
        if (seg == 1) {
#pragma unroll
            for (int a = 0; a < 2; ++a)
#pragma unroll
                for (int b = 0; b < 2; ++b)
#pragma unroll
                    for (int m = 0; m < 4; ++m)
#pragma unroll
                        for (int n = 0; n < 2; ++n) acc[a][b][m][n] = (f32x4){0.f, 0.f, 0.f, 0.f};
            cur = nxt; ++ui; }
        cA = nA; cB = nB; nt = nnt; seg ^= 1;
        if (wr == 1) PG8_BAR;
    }
    PG8_WAIT_V(0);
    PG8_BAR;
#undef PG8_SA
#undef PG8_SB
#undef PG8_STAGE
#undef PG8_LDA
#undef PG8_LDB
#undef PG8_MMA
#undef PG8_WAIT_V
#undef PG8_WAIT_L
#undef PG8_BAR
#undef PG8_SCHED
}
}
using pg8::cvt_pk_bf16;

__device__ __forceinline__ float wave_sum(float v) {
#pragma unroll
    for (int o = 1; o < 64; o <<= 1) v += __shfl_xor(v, o);
    return v;
}
__device__ __forceinline__ s16x4 vtr(LAS const unsigned char* p) { return __builtin_bit_cast(s16x4, __builtin_amdgcn_ds_read_tr16_b64_v4i16((LAS s16x4*)p)); }

__device__ __forceinline__ void p0_transpose_item(const float* W, int K, int N, bf16_t* WT, const float* gk, LAS float* scr, int item, int lane, int ldw = 0) {
    if (ldw == 0) ldw = K;
    const int nblk = N / 32, kb = item / nblk, nb = item % nblk, k0 = 64 * kb, n0 = 32 * nb;
#pragma unroll
    for (int i = 0; i < 32; ++i) { const int kk = 2 * i + (lane >> 5); float w = W[(size_t)(k0 + kk) * N + n0 + (lane & 31)]; if (gk) w *= gk[k0 + kk]; scr[kk * 33 + (lane & 31)] = w; }
    asm volatile("s_waitcnt lgkmcnt(0)" ::: "memory");
    const int c = lane & 7;
#pragma unroll
    for (int j = 0; j < 4; ++j) { const int n = (lane >> 3) + 8 * j; const LAS float* s = scr + (8 * c) * 33 + n;
        u32x4 o; o.x = cvt_pk_bf16(s[0 * 33], s[1 * 33]); o.y = cvt_pk_bf16(s[2 * 33], s[3 * 33]); o.z = cvt_pk_bf16(s[4 * 33], s[5 * 33]); o.w = cvt_pk_bf16(s[6 * 33], s[7 * 33]);
        *(u32x4*)(WT + (size_t)(n0 + n) * ldw + k0 + 8 * c) = o; }
    asm volatile("s_waitcnt lgkmcnt(0)" ::: "memory");
}
__device__ __forceinline__ void hprep_rows(const float* x, bf16_t* h, float* rsx, int gw, int ngw, int lane) {
    for (int m = gw; m < MC / 2; m += ngw) {
        const f32x4* xa = (const f32x4*)(x + (size_t)m * DM) + lane; const f32x4* xb = (const f32x4*)(x + (size_t)(m + MC / 2) * DM) + lane;
        f32x4 va[4], vb[4]; float sa = 0.f, sb = 0.f;
#pragma unroll
        for (int j = 0; j < 4; ++j) { va[j] = xa[64 * j]; vb[j] = xb[64 * j]; }
#pragma unroll
        for (int j = 0; j < 4; ++j) { sa += pg8::dot4(va[j]); sb += pg8::dot4(vb[j]); }
        const float ma = wave_sum(sa) * (1.0f / DM) + EPS, mb = wave_sum(sb) * (1.0f / DM) + EPS;
        const float ra = __builtin_amdgcn_rsqf(ma), rb = __builtin_amdgcn_rsqf(mb);
        if (lane == 0) { rsx[m] = ma * ra; rsx[m + MC / 2] = mb * rb; }
        u32x2* oa = (u32x2*)(h + (size_t)m * DM) + lane; u32x2* ob = (u32x2*)(h + (size_t)(m + MC / 2) * DM) + lane;
#pragma unroll
        for (int j = 0; j < 4; ++j) { u32x2 w; w.x = cvt_pk_bf16(va[j][0] * ra, va[j][1] * ra); w.y = cvt_pk_bf16(va[j][2] * ra, va[j][3] * ra); oa[64 * j] = w;
            u32x2 z; z.x = cvt_pk_bf16(vb[j][0] * rb, vb[j][1] * rb); z.y = cvt_pk_bf16(vb[j][2] * rb, vb[j][3] * rb); ob[64 * j] = z; }
    }
}
__device__ __forceinline__ void final_norm_rows(float* xo, const float* rowsq, const float* gfin, int gw, int ngw, int lane) {
    f32x4 gv[4];
#pragma unroll
    for (int j = 0; j < 4; ++j) gv[j] = ((const f32x4*)gfin)[lane + 64 * j];
    for (int m = gw; m < MC / 2; m += ngw) {
        f32x4* xa = (f32x4*)(xo + (size_t)m * DM) + lane; f32x4* xb = (f32x4*)(xo + (size_t)(m + MC / 2) * DM) + lane;
        const float qa = rowsq[m], qb = rowsq[m + MC / 2];
        f32x4 va[4], vb[4];
#pragma unroll
        for (int j = 0; j < 4; ++j) { va[j] = xa[64 * j]; vb[j] = xb[64 * j]; }
        const float ra = __builtin_amdgcn_rsqf(qa * (1.0f / DM) + EPS), rb = __builtin_amdgcn_rsqf(qb * (1.0f / DM) + EPS);
#pragma unroll
        for (int j = 0; j < 4; ++j) { xa[64 * j] = va[j] * ra * gv[j]; xb[64 * j] = vb[j] * rb * gv[j]; }
    }
}

__device__ __forceinline__ void att_dma16(const void* g, LAS void* l) {
    asm volatile("s_mov_b32 m0, %0\n\ts_nop 0\n\tglobal_load_lds_dwordx4 %1, off" :: "s"((unsigned)(size_t)l), "v"(g) : "memory", "m0");
}
struct AUnit { int g, hj, seq, r, m0, dsh, L; };
__device__ __forceinline__ void attn_decode(int uid, bool combine, int S, AUnit& u) {
    int rem; if (combine) { u.g = 0; rem = uid; } else { u.g = 1 + (uid >> 11); rem = uid & 2047; }
    u.hj = rem & 7; const int blk = rem >> 3;
    u.dsh = 2 * u.g;
    const int lgb = (S == 4096) ? 5 : 6;
    u.seq = blk >> lgb; const int bs = blk & ((1 << lgb) - 1);
    u.L = S >> u.dsh; const int lgr = lgb - u.dsh;
    u.r = bs >> lgr; u.m0 = (bs & ((1 << lgr) - 1)) << 7;
}
template <bool COMBINE>
__device__ __forceinline__ void attn_phase(LAS unsigned char* lds, const bf16_t* qkv, int S, bf16_t* po, float* ps, bf16_t* attn, int vcu, int G, int tid, int lane, int wave) {
    const int nunits = COMBINE ? 2048 : 4096;
    const int fr = lane & 15, fq = lane >> 4;
    bf16x8 qn0, qn1;
    int uid = vcu; if (uid >= nunits) return;
    AUnit cur; attn_decode(uid, COMBINE, S, cur);
#define ATT_STAGE(U, B) do { _Pragma("unroll") for (int i = 0; i < 4; ++i) { const int seg = wave * 4 + i, row = seg * 8 + (lane >> 3), cp = lane & 7; const int mm = (U).m0 - 64 + row; \
        const bool ok = (mm >= 0) && (mm < (U).L); const size_t grow = (size_t)(U).seq * S + ((size_t)(ok ? mm : 0) << (U).dsh) + (U).r; \
        const bf16_t* p = qkv + grow * QKV_W + 1536 + (U).g * 512 + (U).hj * 64; \
        const int chk = cp ^ (row & 7), chv = cp ^ ((((row >> 1) & 1) << 1) | (((row >> 2) & 1) << 2)); \
        att_dma16(p + chk * 8, lds + (B) * 65536 + seg * 1024); \
        att_dma16(p + 1536 + chv * 8, lds + (B) * 65536 + 32768 + seg * 1024); } \
        { const int mq_ = (U).m0 + 16 * wave + fr; const size_t rq_ = (size_t)(U).seq * S + ((size_t)mq_ << (U).dsh) + (U).r; \
          const bf16_t* qp_ = qkv + rq_ * QKV_W + (U).g * 512 + (U).hj * 64 + 8 * fq; qn0 = *(const bf16x8*)qp_; qn1 = *(const bf16x8*)(qp_ + 32); } } while (0)
    int buf = 0;
    ATT_STAGE(cur, 0);
    asm volatile("s_waitcnt vmcnt(0)" ::: "memory");
    for (;;) {
        asm volatile("s_waitcnt vmcnt(4)" ::: "memory");
        __syncthreads();
        LAS unsigned char* kimg = lds + buf * 65536; LAS unsigned char* vimg = kimg + 32768;
        const int mq = cur.m0 + 16 * wave + fr;
        const size_t rowq = (size_t)cur.seq * S + ((size_t)mq << cur.dsh) + cur.r;
        const bf16x8 qf0 = qn0, qf1 = qn1;
        f32x2 s1, s2; u32x2 pa[4], pb[4];
        if constexpr (COMBINE) {
            s1 = *(const f32x2*)(ps + (rowq * 8 + cur.hj) * 2); s2 = *(const f32x2*)(ps + (((size_t)MC + rowq) * 8 + cur.hj) * 2);
            const bf16_t* p1 = po + rowq * AO + cur.hj * 64 + 4 * fq; const bf16_t* p2 = p1 + (size_t)MC * AO;
#pragma unroll
            for (int dt = 0; dt < 4; ++dt) { pa[dt] = *(const u32x2*)(p1 + 16 * dt); pb[dt] = *(const u32x2*)(p2 + 16 * dt); }
        }
        const int nuid = uid + G; const bool hn = nuid < nunits;
        if (hn) { AUnit nxt; attn_decode(nuid, COMBINE, S, nxt); ATT_STAGE(nxt, buf ^ 1); }
        __builtin_amdgcn_sched_barrier(0);
        f32x4 st[9];
        { const int sw = fr & 7; const LAS unsigned char* kb = kimg + (16 * wave + fr) * 128; const int o0 = (fq ^ sw) << 4, o1 = ((4 + fq) ^ sw) << 4;
#pragma unroll
          for (int j = 0; j < 9; ++j) { const bf16x8 k0 = *(const LAS bf16x8*)(kb + j * 2048 + o0), k1 = *(const LAS bf16x8*)(kb + j * 2048 + o1);
              f32x4 z = (f32x4){0.f, 0.f, 0.f, 0.f};
              z = __builtin_amdgcn_mfma_f32_16x16x32_bf16(k0, qf0, z, 0, 0, 0); st[j] = __builtin_amdgcn_mfma_f32_16x16x32_bf16(k1, qf1, z, 0, 0, 0);
              if (j % 3 == 2) __builtin_amdgcn_sched_barrier(0); } }
        const float slope = __builtin_amdgcn_exp2f(-(float)(cur.g * 8 + cur.hj + 1) * (8.0f / 24.0f));
        const float c2 = slope * (float)(1 << cur.dsh) * LOG2E, sc2 = 0.125f * LOG2E;
        float mx = -3.0e38f;
        if ((cur.m0 == 0) || (cur.m0 + 128 >= cur.L)) {
#pragma unroll
            for (int j = 0; j < 9; ++j)
#pragma unroll
                for (int e = 0; e < 4; ++e) { const int rel = 16 * j - 64 + 4 * fq + e - fr; const int ar = rel < 0 ? -rel : rel; const int mk = mq + rel;
                    const bool ok = (ar <= 64) && (mk >= 0) && (mk < cur.L);
                    const float s = ok ? (st[j][e] * sc2 - c2 * (float)ar) : -1.0e30f; st[j][e] = s; mx = fmaxf(mx, s); }
        } else {
            const int d0 = 4 * fq - fr; const float c2d = c2 * (float)d0;
#pragma unroll
            for (int j = 0; j < 9; ++j)
#pragma unroll
                for (int e = 0; e < 4; ++e) { const float t = c2 * (float)(16 * j - 64 + e) + c2d;
                    float s;
                    if (j <= 3) s = st[j][e] * sc2 + t; else if (j >= 5) s = st[j][e] * sc2 - t; else s = st[j][e] * sc2 - __builtin_fabsf(t);
                    if (j == 0) s = (d0 + e < 0) ? -1.0e30f : s;
                    if (j == 8) s = (d0 + e > 0) ? -1.0e30f : s;
                    st[j][e] = s; mx = fmaxf(mx, s); }
        }
        mx = fmaxf(mx, __shfl_xor(mx, 16)); mx = fmaxf(mx, __shfl_xor(mx, 32));
        float lsum = 0.f;
#pragma unroll
        for (int j = 0; j < 9; ++j)
#pragma unroll
            for (int e = 0; e < 4; ++e) { const float p = __builtin_amdgcn_exp2f(st[j][e] - mx); st[j][e] = p; lsum += p; }
        lsum += __shfl_xor(lsum, 16); lsum += __shfl_xor(lsum, 32);
        __builtin_amdgcn_sched_barrier(0);
        f32x4 o[4];
#pragma unroll
        for (int dt = 0; dt < 4; ++dt) o[dt] = (f32x4){0.f, 0.f, 0.f, 0.f};
        { const int q = fr >> 2, p = fr & 3; const int fs = ((q >> 1) & 1) | ((fq & 1) << 1);
          const LAS unsigned char* vb = vimg + (16 * wave + 4 * fq + q) * 128 + p * 8;
          int vo[4];
#pragma unroll
          for (int dt = 0; dt < 4; ++dt) vo[dt] = (dt ^ fs) << 5;
#pragma unroll
          for (int kk = 0; kk < 5; ++kk) {
              u32x4 pw; pw.x = cvt_pk_bf16(st[2 * kk][0], st[2 * kk][1]); pw.y = cvt_pk_bf16(st[2 * kk][2], st[2 * kk][3]);
              if (kk < 4) { pw.z = cvt_pk_bf16(st[2 * kk + 1 < 9 ? 2 * kk + 1 : 8][0], st[2 * kk + 1 < 9 ? 2 * kk + 1 : 8][1]); pw.w = cvt_pk_bf16(st[2 * kk + 1 < 9 ? 2 * kk + 1 : 8][2], st[2 * kk + 1 < 9 ? 2 * kk + 1 : 8][3]); }
              else { pw.z = 0u; pw.w = 0u; }
              const bf16x8 pf = __builtin_bit_cast(bf16x8, pw);
              const int T0 = 2 * kk, T1 = (2 * kk + 1 < 9) ? 2 * kk + 1 : 8;
#pragma unroll
              for (int dt = 0; dt < 4; ++dt) { const s16x4 a = vtr(vb + T0 * 2048 + vo[dt]), b = vtr(vb + T1 * 2048 + vo[dt]);
                  const bf16x8 vf = __builtin_shufflevector(a, b, 0, 1, 2, 3, 4, 5, 6, 7);
                  o[dt] = __builtin_amdgcn_mfma_f32_16x16x32_bf16(vf, pf, o[dt], 0, 0, 0); }
              __builtin_amdgcn_sched_barrier(0); } }
        if constexpr (!COMBINE) {
            const float inv = 1.0f / lsum; const size_t prow = (size_t)(cur.g - 1) * MC + rowq;
            bf16_t* op = po + prow * AO + cur.hj * 64 + 4 * fq;
#pragma unroll
            for (int dt = 0; dt < 4; ++dt) { u32x2 w; w.x = cvt_pk_bf16(o[dt][0] * inv, o[dt][1] * inv); w.y = cvt_pk_bf16(o[dt][2] * inv, o[dt][3] * inv); *(u32x2*)(op + 16 * dt) = w; }
            if (fq == 0) *(f32x2*)(ps + (prow * 8 + cur.hj) * 2) = (f32x2){mx, lsum};
        } else {
            const float Mx = fmaxf(mx, fmaxf(s1.x, s2.x));
            const float e0 = __builtin_amdgcn_exp2f(mx - Mx), w1 = s1.y * __builtin_amdgcn_exp2f(s1.x - Mx), w2 = s2.y * __builtin_amdgcn_exp2f(s2.x - Mx);
            const float invW = 1.0f / (lsum * e0 + w1 + w2);
            bf16_t* op = attn + rowq * DM + cur.hj * 64 + 4 * fq;
#pragma unroll
            for (int dt = 0; dt < 4; ++dt) { const u32x2 a = pa[dt], b = pb[dt];
                const float r0 = (o[dt][0] * e0 + w1 * pg8::bf_lo(a.x) + w2 * pg8::bf_lo(b.x)) * invW, r1 = (o[dt][1] * e0 + w1 * pg8::bf_hi(a.x) + w2 * pg8::bf_hi(b.x)) * invW;
                const float r2 = (o[dt][2] * e0 + w1 * pg8::bf_lo(a.y) + w2 * pg8::bf_lo(b.y)) * invW, r3 = (o[dt][3] * e0 + w1 * pg8::bf_hi(a.y) + w2 * pg8::bf_hi(b.y)) * invW;
                u32x2 w; w.x = cvt_pk_bf16(r0, r1); w.y = cvt_pk_bf16(r2, r3); *(u32x2*)(op + 16 * dt) = w; }
        }
        if (!hn) break;
        uid = nuid; attn_decode(uid, COMBINE, S, cur); buf ^= 1;
    }
#undef ATT_STAGE
    asm volatile("s_waitcnt vmcnt(0)" ::: "memory");
    __syncthreads();
}

__device__ __forceinline__ void sgu_phase(LAS unsigned char* lds, const bf16_t* uv, const float* rowsq, const float* w_s, const float* b_s, const float* g_sgu, bf16_t* sgu,
                                          int vcu, int G, int tid, int lane, int wave) {
    const int nunits = 2048; const int fr = lane & 15, fq = lane >> 4;
    LAS float* rsl = (LAS float*)(lds + 32768);
    u32x4 vreg[4];
    int uid = vcu; if (uid >= nunits) return;
#define SGU_PREFETCH(UID) do { const int cgp_ = (UID) & 7, pc_ = (UID) >> 3; _Pragma("unroll") for (int i = 0; i < 4; ++i) { const int idx = tid + 512 * i, row = idx >> 4, ch = idx & 15; \
        vreg[i] = *(const u32x4*)(uv + (size_t)(pc_ * 128 + row) * UV_W + 1024 + cgp_ * 128 + ch * 8); } } while (0)
    SGU_PREFETCH(uid);
    for (;;) {
        const int cgp = uid & 7, pc = uid >> 3;
        __syncthreads();
#pragma unroll
        for (int i = 0; i < 4; ++i) { const int idx = tid + 512 * i, row = idx >> 4, ch = idx & 15;
            *(LAS u32x4*)(lds + 256 * row + 16 * (ch ^ (((row & 3) << 2) | ((row >> 2) & 3)))) = vreg[i]; }
        if (tid < 128) rsl[tid] = __builtin_amdgcn_rsqf(rowsq[pc * 128 + tid] * (1.0f / DM) + EPS);
        __syncthreads();
        const int nuid = uid + G; const bool hn = nuid < nunits;
        if (hn) SGU_PREFETCH(nuid);
        f32x4 acc[8];
#pragma unroll
        for (int ct = 0; ct < 8; ++ct) acc[ct] = (f32x4){0.f, 0.f, 0.f, 0.f};
        const float* wrow = w_s + ((size_t)cgp * 128 + 16 * wave + fr) * 128 + 8 * fq;
        const int q = fr >> 2, p = fr & 3;
#pragma unroll
        for (int ks = 0; ks < 4; ++ks) {
            const f32x4 w0 = *(const f32x4*)(wrow + 32 * ks), w1 = *(const f32x4*)(wrow + 32 * ks + 4);
            const f32x4 r0 = *(const LAS f32x4*)(rsl + 32 * ks + 8 * fq), r1 = *(const LAS f32x4*)(rsl + 32 * ks + 8 * fq + 4);
            const bf16x8 wf = __builtin_bit_cast(bf16x8, pg8::pack8(w0 * r0, w1 * r1));
            const int ra = 32 * ks + 8 * fq + q, rb = ra + 4;
            const int xa = ((ra & 3) << 2) | ((ra >> 2) & 3), xb = ((rb & 3) << 2) | ((rb >> 2) & 3);
#pragma unroll
            for (int ct = 0; ct < 8; ++ct) { const int ch = 2 * ct + (p >> 1);
                const s16x4 a = vtr(lds + 256 * ra + 16 * (ch ^ xa) + 8 * (p & 1)), b = vtr(lds + 256 * rb + 16 * (ch ^ xb) + 8 * (p & 1));
                const bf16x8 vf = __builtin_shufflevector(a, b, 0, 1, 2, 3, 4, 5, 6, 7);
                acc[ct] = __builtin_amdgcn_mfma_f32_16x16x32_bf16(vf, wf, acc[ct], 0, 0, 0); } }
        const int t = 16 * wave + fr; const size_t row = (size_t)pc * 128 + t; const float bt = b_s[cgp * 128 + t];
#pragma unroll
        for (int ct = 0; ct < 8; ++ct) { const int c0 = cgp * 128 + 16 * ct + 4 * fq;
            const f32x4 gv = *(const f32x4*)(g_sgu + c0); const u32x2 uw = *(const u32x2*)(uv + row * UV_W + c0);
            const f32x4 mixed = acc[ct] * gv + bt;
            const f32x4 uu = (f32x4){pg8::bf_lo(uw.x), pg8::bf_hi(uw.x), pg8::bf_lo(uw.y), pg8::bf_hi(uw.y)};
            const f32x4 ov = uu * mixed; u32x2 w; w.x = cvt_pk_bf16(ov[0], ov[1]); w.y = cvt_pk_bf16(ov[2], ov[3]);
            *(u32x2*)(sgu + row * DM + c0) = w; }
        if (!hn) break;
        uid = nuid;
    }
#undef SGU_PREFETCH
    __syncthreads();
}


#define XB_TMO      128
#define XB_XCNT(j)  (256  + 64 * (j))
#define XB_XSUB(j)  (1280 + 64 * (j))
#define XB_XGEN(j)  (2304 + 64 * (j))
#define XB_TOP      3328
#define XB_TOPGEN   3392
#define XCD_BAR_WORDS 3456
#define XB_SPIN_CAP (1u << 22)
__device__ __forceinline__ unsigned xb_ld(unsigned* p)              { return __hip_atomic_load(p, __ATOMIC_RELAXED, __HIP_MEMORY_SCOPE_AGENT); }
__device__ __forceinline__ unsigned xb_add(unsigned* p, unsigned v) { return __hip_atomic_fetch_add(p, v, __ATOMIC_RELAXED, __HIP_MEMORY_SCOPE_AGENT); }
__device__ __forceinline__ unsigned xb_xcc_id() { return (unsigned)__builtin_amdgcn_s_getreg((3 << 11) | 20) & 0xFu; }
#define XB_SPIN(cond, bar) do { unsigned _sp = 0; while (cond) { __builtin_amdgcn_s_sleep(1); \
    if ((++_sp & 255u) == 0u) { if (xb_ld(&(bar)[XB_TMO])) break; if (_sp > XB_SPIN_CAP) { atomicAdd(&(bar)[XB_TMO], 1u); break; } } } } while (0)
struct XcdBarrier { unsigned* bar; unsigned x; volatile LAS unsigned* st; };
__device__ __forceinline__ XcdBarrier xcd_barrier_post(unsigned* bar, volatile LAS unsigned* st) {
    XcdBarrier b; b.bar = bar; b.x = xb_xcc_id(); b.st = st;
    if (threadIdx.x == 0) (void)xb_add(&bar[XB_XCNT(b.x)], 1u);
    return b;
}
__device__ __forceinline__ void xcd_barrier_complete(unsigned* bar, unsigned x, unsigned& nloc, unsigned& nx) {
    const unsigned G = gridDim.x * gridDim.y * gridDim.z;
    unsigned sum, cnt, mine, sp = 0u;
    for (;;) {
        sum = 0u; cnt = 0u; mine = 0u;
#pragma unroll
        for (unsigned j = 0; j < 16; ++j) { const unsigned c = xb_ld(&bar[XB_XCNT(j)]); sum += c; cnt += (c > 0u) ? 1u : 0u; mine = (j == x) ? c : mine; }
        if (sum == G) break;
        __builtin_amdgcn_s_sleep(1);
        if ((++sp & 255u) == 0u) { if (xb_ld(&bar[XB_TMO])) break; if (sp > XB_SPIN_CAP) { atomicAdd(&bar[XB_TMO], 1u); break; } }
    }
    nloc = mine > 0u ? mine : 1u; nx = cnt > 0u ? cnt : 1u;
}
__device__ __forceinline__ void xcd_barrier(const XcdBarrier& b) {
    asm volatile("s_waitcnt vmcnt(0)" ::: "memory");
    __syncthreads();
    if (threadIdx.x == 0) {
        unsigned* bar = b.bar;
        __builtin_amdgcn_s_waitcnt(0);
        unsigned nloc = b.st[0], nx = b.st[1];
        if (nloc == 0u) { xcd_barrier_complete(bar, b.x, nloc, nx); b.st[0] = nloc; b.st[1] = nx; }
        const unsigned old = xb_add(&bar[XB_XSUB(b.x)], 1u);
        const unsigned gen = old / nloc;
        if (old + 1u == (gen + 1u) * nloc) {
            __builtin_amdgcn_fence(__ATOMIC_RELEASE, "agent");
            asm volatile("s_waitcnt vmcnt(0)" ::: "memory");
            const unsigned og = xb_add(&bar[XB_TOP], 1u);
            const unsigned tg = og / nx;
            if (og + 1u == (tg + 1u) * nx) xb_add(&bar[XB_TOPGEN], 1u);
            else XB_SPIN(xb_ld(&bar[XB_TOPGEN]) == tg, bar);
            __builtin_amdgcn_fence(__ATOMIC_ACQUIRE, "agent");
            xb_add(&bar[XB_XGEN(b.x)], 1u);
            asm volatile("s_waitcnt vmcnt(0)" ::: "memory");
        } else {
            XB_SPIN(xb_ld(&bar[XB_XGEN(b.x)]) == gen, bar);
            __builtin_amdgcn_fence(__ATOMIC_ACQUIRE, "agent");
            asm volatile("s_waitcnt vmcnt(0)" ::: "memory");
        }
    }
    __syncthreads();
}

struct Args { const float* in[14]; float* out; unsigned char* ws; int ph_lo, ph_hi; };
constexpr int N_PHASES = 22;

__global__ void __launch_bounds__(512, 2) mega_fwd(Args a) {
    extern __shared__ __attribute__((aligned(16))) unsigned char lds_raw[];
    LAS unsigned char* lds = (LAS unsigned char*)lds_raw;
    cg::grid_group grid = cg::this_grid();
    const int G = gridDim.x, bx = blockIdx.x;
    const int vcu = (G % 8 == 0) ? (bx % 8) * (G / 8) + bx / 8 : bx;
    volatile LAS unsigned* misc = (volatile LAS unsigned*)(lds + LDS_MISC_OFF);
    if (threadIdx.x < 2) misc[threadIdx.x] = 0u;
    __syncthreads();
    const XcdBarrier xbar = xcd_barrier_post((unsigned*)(a.ws + WS_BAR), misc);
    grid.sync();
#define WSP(T, off) ((T*)(ws + (off)))
    for (int ph = a.ph_lo; ph < a.ph_hi; ++ph) {
        if (ph != a.ph_lo) xcd_barrier(xbar);
        size_t zoff = 0; asm volatile("" : "+s"(zoff)); unsigned char* ws = a.ws + zoff;
        int tid = threadIdx.x; asm volatile("" : "+v"(tid));
        const int lane = tid & 63, wave = __builtin_amdgcn_readfirstlane(tid >> 6);
        const int gw = vcu * 8 + wave, ngw = G * 8;
        if (ph == 0) {
            LAS float* scr = (LAS float*)(lds + wave * 16384);
            constexpr int I_IN = (DM / 64) * (IN_COLS / 32), I_A = (AO / 64) * (DM / 32), I_B = (DM / 64) * (DM / 32), I_O = I_B, I_UP = (DM / 64) * (FF / 32), I_DN = (FF / 64) * (DM / 32);
            constexpr int NITEMS = I_IN + I_A + I_B + I_O + I_UP + I_DN;
            for (int it = gw; it < I_IN; it += ngw) p0_transpose_item(a.in[3], DM, IN_COLS, WSP(bf16_t, WS_WIN), a.in[2], scr, it, lane);
            hprep_rows(a.in[0], WSP(bf16_t, WS_H), WSP(float, WS_RSX), gw, ngw, lane);
            for (int i = gw * 64 + lane; i < (int)(CTL_BYTES / 16); i += ngw * 64) WSP(f32x4, WS_CTL)[i] = (f32x4){0.f, 0.f, 0.f, 0.f};
            continue;
        }
        const int c = (ph - 1) / 7, k = (ph - 1) % 7;
        const float* xin = (c < 2) ? a.in[0] + (size_t)c * MC * DM : a.in[1];
        float* xout = a.out + (size_t)c * MC * DM;
        const int S = (c < 2) ? 4096 : 8192;
        float* rsqv = WSP(float, OFF_RSQV) + c * MC; float* rsq1 = WSP(float, OFF_RSQ1) + c * MC; float* rsq2 = WSP(float, OFF_RSQ2) + c * MC;
        if (k == 0) {
            pg8::Gemm g{WSP(bf16_t, WS_H), WSP(bf16_t, WS_WIN), MC, IN_COLS, DM}; pg8::StaticOrder So; So.init(MC, IN_COLS, G, bx);
            pg8::EpiProj E{WSP(bf16_t, WS_QKV), WSP(bf16_t, WS_UV), WSP(bf16_t, WS_GG), rsqv};
            pg8::gemm_phase<pg8::EpiProj, pg8::StaticOrder, true, true>(lds, g, So, E);
        } else if (k == 1) {
            if (c == 0) {
                LAS float* scr = (LAS float*)(lds + wave * 16384);
                constexpr int I_A = (AO / 64) * (DM / 32), I_B = (DM / 64) * (DM / 32), I_O = I_B, I_UP = (DM / 64) * (FF / 32), I_DN = (FF / 64) * (DM / 32);
                for (int it = gw; it < I_A + I_B + I_O + I_UP + I_DN; it += ngw) {
                    int r = it;
                    if (r < I_A) { p0_transpose_item(a.in[7], AO, DM, WSP(bf16_t, WS_WA), nullptr, scr, r, lane, DM); continue; } r -= I_A;
                    if (r < I_B) { p0_transpose_item(a.in[8], DM, DM, WSP(bf16_t, WS_WB), nullptr, scr, r, lane); continue; } r -= I_B;
                    if (r < I_O) { p0_transpose_item(a.in[9], DM, DM, WSP(bf16_t, WS_WO), nullptr, scr, r, lane); continue; } r -= I_O;
                    if (r < I_UP) { p0_transpose_item(a.in[11], DM, FF, WSP(bf16_t, WS_WUP), a.in[10], scr, r, lane); continue; } r -= I_UP;
                    p0_transpose_item(a.in[12], FF, DM, WSP(bf16_t, WS_WDN), nullptr, scr, r, lane);
                }
                __syncthreads();
            }
            if (!(EXP_SKIP_MIX & 1)) attn_phase<false>(lds, WSP(bf16_t, WS_QKV), S, WSP(bf16_t, WS_PO), WSP(float, WS_PS), WSP(bf16_t, WS_ATTN), vcu, G, tid, lane, wave);
        } else if (k == 2) {
            if (EXP_SKIP_MIX & 1) { for (size_t i = (size_t)gw * 64 + lane; i < (size_t)MC * AO / 8; i += (size_t)ngw * 64) WSP(u32x4, WS_ATTN)[i] = (EXP_SKIP_MIX & 4) ? *(const u32x4*)(WSP(bf16_t, WS_QKV) + (i >> 6) * QKV_W + (i & 63) * 8) : (u32x4){0u, 0u, 0u, 0u}; }
            else attn_phase<true>(lds, WSP(bf16_t, WS_QKV), S, WSP(bf16_t, WS_PO), WSP(float, WS_PS), WSP(bf16_t, WS_ATTN), vcu, G, tid, lane, wave);
            if (EXP_SKIP_MIX & 2) { for (size_t i = (size_t)gw * 64 + lane; i < (size_t)MC * DM / 8; i += (size_t)ngw * 64) WSP(u32x4, WS_SGU)[i] = (EXP_SKIP_MIX & 4) ? *(const u32x4*)(WSP(bf16_t, WS_UV) + (i >> 7) * UV_W + (i & 127) * 8) : (u32x4){0u, 0u, 0u, 0u}; }
            else sgu_phase(lds, WSP(bf16_t, WS_UV), rsqv, a.in[4], a.in[5], a.in[6], WSP(bf16_t, WS_SGU), vcu, G, tid, lane, wave);
        } else if (k == 3 && (EXP_SKIP_MIX & 8)) {
            for (size_t i = (size_t)gw * 64 + lane; i < (size_t)MC * DM / 8; i += (size_t)ngw * 64) WSP(u32x4, WS_MERGED)[i] = *(const u32x4*)(WSP(bf16_t, WS_GG) + (i >> 7) * GG_W + ((i >> 7) & 1) * 1024 + (i & 127) * 8);
        } else if (k == 3) {
            pg8::StaticOrder So; So.init(MC, DM, G, bx);
            pg8::EpiMid Mh{WSP(bf16_t, WS_GG)}; pg8::EpiMerge E{WSP(bf16_t, WS_GG), WSP(bf16_t, WS_MERGED)};
            pg8::gemm_phase_dual<pg8::EpiMid, pg8::EpiMerge, pg8::StaticOrder>(lds, WSP(bf16_t, WS_ATTN), WSP(bf16_t, WS_WA), AO / 64, WSP(bf16_t, WS_SGU), WSP(bf16_t, WS_WB), DM / 64, DM, So, Mh, E);
        } else if (k == 4) {
            pg8::Gemm g{WSP(bf16_t, WS_MERGED), WSP(bf16_t, WS_WO), MC, DM, DM}; pg8::StaticOrder So; So.init(MC, DM, G, bx);
            pg8::EpiRes<true> E{WSP(bf16_t, WS_H), WSP(float, WS_RSX) + (size_t)c * MC, xout, WSP(bf16_t, WS_X1B), rsq1};
            pg8::gemm_phase<pg8::EpiRes<true>, pg8::StaticOrder, true, true>(lds, g, So, E);
        } else if (k == 5) {
            if (c + 1 < NCHUNK) { const float* xn = (c + 1 < 2) ? a.in[0] + (size_t)(c + 1) * MC * DM : a.in[1]; hprep_rows(xn, WSP(bf16_t, WS_H), WSP(float, WS_RSX) + (size_t)(c + 1) * MC, gw, ngw, lane); }
            pg8::Gemm g{WSP(bf16_t, WS_X1B), WSP(bf16_t, WS_WUP), MC, FF, DM}; pg8::StaticOrder So; So.init(MC, FF, G, bx);
            pg8::EpiUp E{rsq1, WSP(bf16_t, WS_UP)};
            pg8::gemm_phase<pg8::EpiUp, pg8::StaticOrder, true, true>(lds, g, So, E);
        } else {
            pg8::Gemm g{WSP(bf16_t, WS_UP), WSP(bf16_t, WS_WDN), MC, DM, FF}; pg8::StaticOrder So; So.init(MC, DM, G, bx);
            pg8::EpiFinal E{WSP(bf16_t, WS_X1B), xout, rsq2, WSP(unsigned, OFF_PCNT) + (size_t)c * 128 * 64, a.in[13]};
            pg8::gemm_phase<pg8::EpiFinal, pg8::StaticOrder, true, true>(lds, g, So, E);
        }
    }
}

extern "C" void kernel_launch(void* const* d_in, const int* in_sizes, int n_in, void* d_out, int out_size, void* d_ws, size_t ws_size, hipStream_t stream) {
    static int grid = 0;
    if (grid == 0) {
        if (n_in != 14 || out_size != M_ALL * DM || ws_size < WS_END) { fprintf(stderr, "kernel_launch: unexpected shapes (n_in %d out %d ws %zu); nothing launched\n", n_in, out_size, ws_size); grid = -1; return; }
        int dev = 0, cus = 0, per_cu = 0;
        if (hipGetDevice(&dev) != hipSuccess || hipDeviceGetAttribute(&cus, hipDeviceAttributeMultiprocessorCount, dev) != hipSuccess) { grid = -1; return; }
        if (hipFuncSetAttribute((const void*)mega_fwd, hipFuncAttributeMaxDynamicSharedMemorySize, LDS_BYTES) != hipSuccess) { fprintf(stderr, "kernel_launch: hipFuncSetAttribute failed\n"); grid = -1; return; }
        if (hipOccupancyMaxActiveBlocksPerMultiprocessor(&per_cu, (const void*)mega_fwd, 512, LDS_BYTES) != hipSuccess || per_cu < 1) { fprintf(stderr, "kernel_launch: occupancy query gave %d\n", per_cu); per_cu = 1; }
        (void)hipGetLastError();
        grid = cus * per_cu;
    }
    if (grid < 0) return;
    (void)hipMemsetAsync((char*)d_ws + WS_BAR, 0, BAR_BYTES, stream);
    Args a{};
    for (int i = 0; i < 14; ++i) a.in[i] = (const float*)d_in[i];
    a.out = (float*)d_out; a.ws = (unsigned char*)d_ws;
#if MK_MULTI
    for (int p = 0; p < N_PHASES; ++p) { a.ph_lo = p; a.ph_hi = p + 1; hipLaunchKernelGGL(mega_fwd, dim3(grid), dim3(512), LDS_BYTES, stream, a); }
#else
    a.ph_lo = 0; a.ph_hi = N_PHASES;
    void* args[] = {&a};
    hipError_t e = hipLaunchCooperativeKernel((const void*)mega_fwd, dim3(grid), dim3(512), args, LDS_BYTES, stream);
    if (e != hipSuccess) fprintf(stderr, "cooperative launch failed: %s (grid %d)\n", hipGetErrorString(e), grid);
#endif
}
```

```cpp
#include <hip/hip_runtime.h>
#include <hip/hip_cooperative_groups.h>
#include <cstdio>
#include <cstdint>
namespace cg = cooperative_groups;

#define LAS __attribute__((address_space(3)))
typedef unsigned short bf16_t;
typedef short bf16x8 __attribute__((ext_vector_type(8)));
typedef short s16x4 __attribute__((ext_vector_type(4)));
typedef float f32x4 __attribute__((ext_vector_type(4)));
typedef float f32x2 __attribute__((ext_vector_type(2)));
typedef unsigned u32x4 __attribute__((ext_vector_type(4)));
typedef unsigned u32x2 __attribute__((ext_vector_type(2)));

constexpr int DM = 1024, MC = 32768, NCHUNK = 3, M_ALL = MC * NCHUNK;
constexpr int IN_COLS = 8704, QKV_W = 4608, UV_W = 2048, GG_W = 2048, FF = 4096, AO = 512;
constexpr float EPS = 1e-6f;
constexpr float LOG2E = 1.4426950408889634f;

constexpr size_t MiB = 1u << 20;
constexpr size_t WS_CTL = 0, CTL_BYTES = 1536 * 1024;
constexpr size_t WS_BAR = 1536 * 1024, BAR_BYTES = 16384;
constexpr int LDS_MISC_OFF = 131072 + 512;
constexpr size_t OFF_RSQV = 0, OFF_RSQ1 = 512 * 1024, OFF_RSQ2 = 1024 * 1024, OFF_PCNT = 1408 * 1024;
constexpr size_t WS_WIN = 4 * MiB, WS_WA = 22 * MiB, WS_WB = 24 * MiB, WS_WO = 26 * MiB, WS_WUP = 28 * MiB, WS_WDN = 36 * MiB;
constexpr size_t WS_H = 48 * MiB;
constexpr size_t WS_QKV = 112 * MiB;
constexpr size_t WS_UV = 400 * MiB;
constexpr size_t WS_GG = 528 * MiB;
constexpr size_t WS_PO = 656 * MiB;
constexpr size_t WS_PS = 720 * MiB;
constexpr size_t WS_ATTN = 724 * MiB;
constexpr size_t WS_SGU = 788 * MiB;
constexpr size_t WS_END = 852 * MiB;
constexpr size_t WS_T1 = WS_QKV;
constexpr size_t WS_MERGED = WS_QKV + 128 * MiB;
constexpr size_t WS_X1B = WS_QKV + 192 * MiB;
constexpr size_t WS_UP = WS_UV;

constexpr int LDS_BYTES = 147456;
#ifndef MK_MULTI
#define MK_MULTI 0
#endif
#ifndef EXP_SS
#define EXP_SS true
#endif
#ifndef EXP_GMODE
#define EXP_GMODE 2
#endif
#ifndef EXP_SKIP_MIX
#define EXP_SKIP_MIX 0
#endif

namespace pg8 {
constexpr int BM = 256, BK = 64, HALF = 128, HTB = HALF * BK * 2, STAGE_BYTES = 8 * HTB, NXCD = 8, WGM = 8;
__host__ __device__ __forceinline__ int lds_byte(int r, int c) { const int st = (r >> 4) * 2 + (c >> 5), rr = r & 15, cc = c & 31, ob = rr * 64 + cc * 2; return st * 1024 + (ob ^ (((ob >> 9) & 1) << 5)); }
__host__ __device__ __forceinline__ void stage_rc(int b, int& R, int& C) { const int st = b / 1024, sb = b % 1024, swz = sb ^ (((sb >> 9) & 1) << 5); R = (st >> 1) * 16 + swz / 64; C = (st & 1) * 32 + (swz % 64) / 2; }
__host__ __device__ __forceinline__ int perm32(int rho) { const int n = rho >> 4, i = rho & 15; return 8 * (i >> 2) + 4 * n + (i & 3); }

struct Unit { int pm, pn; };
struct Gemm { const bf16_t* A; const bf16_t* Bt; int M, N, K; };

struct StaticOrder {
    int nM, nN, nwg, G, c;
    __host__ __device__ void init(int M, int N, int G_, int c_) { nM = M / BM; nN = N / BM; nwg = nM * nN; G = G_; c = c_; }
    __host__ __device__ bool next(int i, Unit& u) const {
        const long L = (long)i * G + c; if (L >= nwg) return false;
        int wgid = (int)L; { const int q = nwg / NXCD, r = nwg % NXCD, xcd = wgid % NXCD, off = wgid / NXCD; wgid = (xcd < r ? xcd * (q + 1) : r * (q + 1) + (xcd - r) * q) + off; }
        const int nig = WGM * nN, gid = wgid / nig, fm = gid * WGM, gsz = (nM - fm) < WGM ? (nM - fm) : WGM;
        u.pm = fm + ((wgid % nig) % gsz); u.pn = (wgid % nig) / gsz; return true;
    }
    __device__ __forceinline__ void a_ready(const Unit&) const {}
    __device__ __forceinline__ void done(const Unit&) const {}
};

typedef __bf16 bf16x2_t __attribute__((ext_vector_type(2)));
__device__ __forceinline__ unsigned cvt_pk_bf16(float lo, float hi) { const bf16x2_t r = __builtin_convertvector((f32x2){lo, hi}, bf16x2_t); return __builtin_bit_cast(unsigned, r); }
__device__ __forceinline__ f32x2 gelu_pk(f32x2 v) {
    const f32x2 av = __builtin_elementwise_abs(v), d = av * 0.2316418882f + 1.0f;
    f32x2 t; t.x = __builtin_amdgcn_rcpf(d.x); t.y = __builtin_amdgcn_rcpf(d.y);
    f32x2 q = t * 0.5307027145f + (-0.7265760135f); q = q * t + 0.7107068705f; q = q * t + (-0.142248368f); q = q * t + 0.127414796f; q = q * t;
    const f32x2 s = (v * v) * (-0.72134752044f);
    f32x2 e; e.x = __builtin_amdgcn_exp2f(s.x); e.y = __builtin_amdgcn_exp2f(s.y);
    const f32x2 m = v * (q * e), r = v - m;
    f32x2 o; o.x = v.x < 0.f ? m.x : r.x; o.y = v.y < 0.f ? m.y : r.y; return o;
}
__device__ __forceinline__ f32x4 gelu4(f32x4 v) { f32x2 a = gelu_pk((f32x2){v[0], v[1]}), b = gelu_pk((f32x2){v[2], v[3]}); return (f32x4){a.x, a.y, b.x, b.y}; }
__device__ __forceinline__ float sigm(float x) { return __builtin_amdgcn_rcpf(1.0f + __builtin_amdgcn_exp2f(-x * LOG2E)); }
__device__ __forceinline__ f32x4 sigm4(f32x4 v) { return (f32x4){sigm(v[0]), sigm(v[1]), sigm(v[2]), sigm(v[3])}; }
__device__ __forceinline__ u32x4 pack8(f32x4 v0, f32x4 v1) { u32x4 w; w.x = cvt_pk_bf16(v0[0], v0[1]); w.y = cvt_pk_bf16(v0[2], v0[3]); w.z = cvt_pk_bf16(v1[0], v1[1]); w.w = cvt_pk_bf16(v1[2], v1[3]); return w; }
__device__ __forceinline__ float bf_lo(unsigned w) { return __uint_as_float(w << 16); }
__device__ __forceinline__ float bf_hi(unsigned w) { return __uint_as_float(w & 0xffff0000u); }
__device__ __forceinline__ float dot4(f32x4 v) { return (v[0] * v[0] + v[1] * v[1]) + (v[2] * v[2] + v[3] * v[3]); }

struct EpiProj {
    static constexpr bool PERM = true, AFTER_DRAIN = false;
    bf16_t* qkv; bf16_t* uv; bf16_t* gg; float* rowsq;
    template <int MODE, bool SS>
    __device__ __forceinline__ void tile(const f32x4 (&acc)[2][2][4][2], bf16_t* base, int ld, int row0, int col0) const {
#pragma unroll
        for (int ai = 0; ai < 2; ++ai)
#pragma unroll
            for (int m = 0; m < 4; ++m) { const int row = row0 + ai * HALF + m * 16; bf16_t* rowp = base + (size_t)row * ld + col0; float ss = 0.f;
#pragma unroll
                for (int bj = 0; bj < 2; ++bj) { f32x4 v0 = acc[ai][bj][m][0], v1 = acc[ai][bj][m][1];
                    if (MODE == 1) { v0 = gelu4(v0); v1 = gelu4(v1); }
                    if (MODE == 2) { v0 = sigm4(v0); v1 = sigm4(v1); }
                    if (SS) ss += dot4(v0) + dot4(v1);
                    *(u32x4*)(rowp + bj * HALF) = pack8(v0, v1); }
                if (SS) { ss += __shfl_xor(ss, 16); ss += __shfl_xor(ss, 32); if ((threadIdx.x & 48) == 0) unsafeAtomicAdd(rowsq + row, ss); }
                asm volatile("" ::: "memory"); }
    }
    __device__ __forceinline__ void operator()(const f32x4 (&acc)[2][2][4][2], const Unit& u, int wr, int wc, int fr, int fq) const {
        const int pn = u.pn, row0 = u.pm * BM + wr * 64 + fr, cw = wc * 32 + 8 * fq;
        if (pn < 18) {
#pragma unroll
            for (int ai = 0; ai < 2; ++ai)
#pragma unroll
                for (int m = 0; m < 4; ++m) { const int row = row0 + ai * HALF + m * 16;
#pragma unroll
                    for (int bj = 0; bj < 2; ++bj) { const int hh = pn * 4 + bj * 2 + (wc >> 1);
                        *(u32x4*)(qkv + ((size_t)hh * MC + row) * 64 + (wc & 1) * 32 + 8 * fq) = pack8(acc[ai][bj][m][0], acc[ai][bj][m][1]); }
                    asm volatile("" ::: "memory"); }
        }
        else if (pn < 22) tile<1, false>(acc, uv, UV_W, row0, (pn - 18) * 256 + cw);
        else if (pn < 26) tile<1, EXP_SS>(acc, uv, UV_W, row0, (pn - 18) * 256 + cw);
        else tile<EXP_GMODE, false>(acc, gg, GG_W, row0, (pn - 26) * 256 + cw);
    }
};
struct EpiM1 {
    static constexpr bool PERM = true, AFTER_DRAIN = false;
    const bf16_t* gate; bf16_t* t1;
    __device__ __forceinline__ void operator()(const f32x4 (&acc)[2][2][4][2], const Unit& u, int wr, int wc, int fr, int fq) const {
        const int row0 = u.pm * BM + wr * 64 + fr, col0 = u.pn * BM + wc * 32 + 8 * fq;
#pragma unroll
        for (int ai = 0; ai < 2; ++ai)
#pragma unroll
            for (int m = 0; m < 4; ++m) { const size_t row = row0 + ai * HALF + m * 16;
#pragma unroll
                for (int bj = 0; bj < 2; ++bj) { const u32x4 gw = *(const u32x4*)(gate + row * GG_W + col0 + bj * HALF);
                    f32x4 v0 = acc[ai][bj][m][0], v1 = acc[ai][bj][m][1];
                    v0 = v0 * (f32x4){bf_lo(gw.x), bf_hi(gw.x), bf_lo(gw.y), bf_hi(gw.y)}; v1 = v1 * (f32x4){bf_lo(gw.z), bf_hi(gw.z), bf_lo(gw.w), bf_hi(gw.w)};
                    *(u32x4*)(t1 + row * DM + col0 + bj * HALF) = pack8(v0, v1); }
                if (m & 1) asm volatile("" ::: "memory"); }
    }
};
struct EpiM2 {
    static constexpr bool PERM = true, AFTER_DRAIN = false;
    const bf16_t* gate; const bf16_t* t1; bf16_t* merged;
    __device__ __forceinline__ void operator()(const f32x4 (&acc)[2][2][4][2], const Unit& u, int wr, int wc, int fr, int fq) const {
        const int row0 = u.pm * BM + wr * 64 + fr, col0 = u.pn * BM + wc * 32 + 8 * fq;
#pragma unroll
        for (int ai = 0; ai < 2; ++ai)
#pragma unroll
            for (int m = 0; m < 4; ++m) { const size_t row = row0 + ai * HALF + m * 16;
#pragma unroll
                for (int bj = 0; bj < 2; ++bj) { const u32x4 gw = *(const u32x4*)(gate + row * GG_W + col0 + bj * HALF);
                    const u32x4 tw = *(const u32x4*)(t1 + row * DM + col0 + bj * HALF); const f32x4 a0 = (f32x4){bf_lo(tw.x), bf_hi(tw.x), bf_lo(tw.y), bf_hi(tw.y)}, a1 = (f32x4){bf_lo(tw.z), bf_hi(tw.z), bf_lo(tw.w), bf_hi(tw.w)};
                    f32x4 v0 = acc[ai][bj][m][0], v1 = acc[ai][bj][m][1];
                    v0 = a0 + v0 * (f32x4){bf_lo(gw.x), bf_hi(gw.x), bf_lo(gw.y), bf_hi(gw.y)}; v1 = a1 + v1 * (f32x4){bf_lo(gw.z), bf_hi(gw.z), bf_lo(gw.w), bf_hi(gw.w)};
                    *(u32x4*)(merged + row * DM + col0 + bj * HALF) = pack8(v0, v1); }
                if (m & 1) asm volatile("" ::: "memory"); }
    }
};
struct EpiMid {
    const bf16_t* gg;
    __device__ __forceinline__ void operator()(f32x4 (&acc)[2][2][4][2], const Unit& u, int wr, int wc, int fr, int fq) const {
        const int row0 = u.pm * BM + wr * 64 + fr, col0 = u.pn * BM + wc * 32 + 8 * fq;
#pragma unroll
        for (int ai = 0; ai < 2; ++ai)
#pragma unroll
            for (int m = 0; m < 4; ++m) { const size_t row = row0 + ai * HALF + m * 16;
#pragma unroll
                for (int bj = 0; bj < 2; ++bj) { const u32x4 aw = *(const u32x4*)(gg + row * GG_W + col0 + bj * HALF), bw = *(const u32x4*)(gg + row * GG_W + 1024 + col0 + bj * HALF);
                    const f32x4 sa0 = (f32x4){bf_lo(aw.x), bf_hi(aw.x), bf_lo(aw.y), bf_hi(aw.y)}, sa1 = (f32x4){bf_lo(aw.z), bf_hi(aw.z), bf_lo(aw.w), bf_hi(aw.w)};
                    f32x4 sb0 = (f32x4){bf_lo(bw.x), bf_hi(bw.x), bf_lo(bw.y), bf_hi(bw.y)}, sb1 = (f32x4){bf_lo(bw.z), bf_hi(bw.z), bf_lo(bw.w), bf_hi(bw.w)};
                    const f32x4 tiny = (f32x4){1e-30f, 1e-30f, 1e-30f, 1e-30f};
                    sb0 = __builtin_elementwise_max(sb0, tiny); sb1 = __builtin_elementwise_max(sb1, tiny);
                    const f32x4 r0 = sa0 * (f32x4){__builtin_amdgcn_rcpf(sb0[0]), __builtin_amdgcn_rcpf(sb0[1]), __builtin_amdgcn_rcpf(sb0[2]), __builtin_amdgcn_rcpf(sb0[3])};
                    const f32x4 r1 = sa1 * (f32x4){__builtin_amdgcn_rcpf(sb1[0]), __builtin_amdgcn_rcpf(sb1[1]), __builtin_amdgcn_rcpf(sb1[2]), __builtin_amdgcn_rcpf(sb1[3])};
                    acc[ai][bj][m][0] *= r0; acc[ai][bj][m][1] *= r1; }
                if (m & 1) asm volatile("" ::: "memory"); }
    }
};
struct EpiMerge {
    const bf16_t* gg; bf16_t* merged;
    __device__ __forceinline__ void operator()(f32x4 (&acc)[2][2][4][2], const Unit& u, int wr, int wc, int fr, int fq) const {
        const int row0 = u.pm * BM + wr * 64 + fr, col0 = u.pn * BM + wc * 32 + 8 * fq;
#pragma unroll
        for (int ai = 0; ai < 2; ++ai)
#pragma unroll
            for (int m = 0; m < 4; ++m) { const size_t row = row0 + ai * HALF + m * 16;
#pragma unroll
                for (int bj = 0; bj < 2; ++bj) { const u32x4 bw = *(const u32x4*)(gg + row * GG_W + 1024 + col0 + bj * HALF);
                    const f32x4 v0 = acc[ai][bj][m][0] * (f32x4){bf_lo(bw.x), bf_hi(bw.x), bf_lo(bw.y), bf_hi(bw.y)}, v1 = acc[ai][bj][m][1] * (f32x4){bf_lo(bw.z), bf_hi(bw.z), bf_lo(bw.w), bf_hi(bw.w)};
                    *(u32x4*)(merged + row * DM + col0 + bj * HALF) = pack8(v0, v1); }
                if (m & 1) asm volatile("" ::: "memory"); }
    }
};
template <bool WB16> struct EpiRes {
    static constexpr bool PERM = true, AFTER_DRAIN = false;
    const float* xi; float* xo; bf16_t* xb; float* rowsq;
    __device__ __forceinline__ void operator()(const f32x4 (&acc)[2][2][4][2], const Unit& u, int wr, int wc, int fr, int fq) const {
        const int row0 = u.pm * BM + wr * 64 + fr, col0 = u.pn * BM + wc * 32 + 8 * fq;
#pragma unroll
        for (int ai = 0; ai < 2; ++ai)
#pragma unroll
            for (int m = 0; m < 4; ++m) { const size_t row = row0 + ai * HALF + m * 16; float ss = 0.f;
#pragma unroll
                for (int bj = 0; bj < 2; ++bj) { const size_t off = row * DM + col0 + bj * HALF;
                    const f32x4 a0 = *(const f32x4*)(xi + off), a1 = *(const f32x4*)(xi + off + 4);
                    const f32x4 v0 = a0 + acc[ai][bj][m][0], v1 = a1 + acc[ai][bj][m][1];
                    ss += dot4(v0) + dot4(v1);
                    if (!WB16) { *(f32x4*)(xo + off) = v0; *(f32x4*)(xo + off + 4) = v1; }
                    if (WB16) *(u32x4*)(xb + off) = pack8(v0, v1); }
                ss += __shfl_xor(ss, 16); ss += __shfl_xor(ss, 32); if ((threadIdx.x & 48) == 0) unsafeAtomicAdd(rowsq + row, ss);
                if (m & 1) asm volatile("" ::: "memory"); }
    }
};
struct EpiFinal {
    static constexpr bool PERM = true, AFTER_DRAIN = false;
    const bf16_t* xi; float* xo; float* rowsq; unsigned* cnt; const float* gfin;
    __device__ __forceinline__ void operator()(f32x4 (&acc)[2][2][4][2], const Unit& u, int wr, int wc, int fr, int fq) const {
        const int row0 = u.pm * BM + wr * 64 + fr, col0 = u.pn * BM + wc * 32 + 8 * fq;
#pragma unroll
        for (int ai = 0; ai < 2; ++ai)
#pragma unroll
            for (int m = 0; m < 4; ++m) { const size_t row = row0 + ai * HALF + m * 16; float ss = 0.f;
#pragma unroll
                for (int bj = 0; bj < 2; ++bj) { const size_t off = row * DM + col0 + bj * HALF;
                    const u32x4 xw = *(const u32x4*)(xi + off);
                    acc[ai][bj][m][0] += (f32x4){bf_lo(xw.x), bf_hi(xw.x), bf_lo(xw.y), bf_hi(xw.y)}; acc[ai][bj][m][1] += (f32x4){bf_lo(xw.z), bf_hi(xw.z), bf_lo(xw.w), bf_hi(xw.w)};
                    ss += dot4(acc[ai][bj][m][0]) + dot4(acc[ai][bj][m][1]); }
                ss += __shfl_xor(ss, 16); ss += __shfl_xor(ss, 32); if ((threadIdx.x & 48) == 0) unsafeAtomicAdd(rowsq + row, ss);
                if (m & 1) asm volatile("" ::: "memory"); }
        asm volatile("s_waitcnt vmcnt(0)" ::: "memory");
        unsigned* pc = cnt + 64 * u.pm;
        if ((threadIdx.x & 63) == 0) __hip_atomic_fetch_add(pc, 1u, __ATOMIC_RELAXED, __HIP_MEMORY_SCOPE_AGENT);
        { unsigned sp = 0;
          while ((unsigned)__builtin_amdgcn_readfirstlane(__hip_atomic_load(pc, __ATOMIC_RELAXED, __HIP_MEMORY_SCOPE_AGENT)) < 32u) { __builtin_amdgcn_s_sleep(1); if (++sp > (1u << 22)) break; } }
        f32x4 gv[2][2];
#pragma unroll
        for (int bj = 0; bj < 2; ++bj) { gv[bj][0] = *(const f32x4*)(gfin + col0 + bj * HALF); gv[bj][1] = *(const f32x4*)(gfin + col0 + bj * HALF + 4); }
#pragma unroll
        for (int ai = 0; ai < 2; ++ai)
#pragma unroll
            for (int m = 0; m < 4; ++m) { const size_t row = row0 + ai * HALF + m * 16;
                const float q = __hip_atomic_load(rowsq + row, __ATOMIC_RELAXED, __HIP_MEMORY_SCOPE_AGENT);
                const float rs = __builtin_amdgcn_rsqf(q * (1.0f / DM) + EPS);
#pragma unroll
                for (int bj = 0; bj < 2; ++bj) { const size_t off = row * DM + col0 + bj * HALF;
                    *(f32x4*)(xo + off) = acc[ai][bj][m][0] * rs * gv[bj][0]; *(f32x4*)(xo + off + 4) = acc[ai][bj][m][1] * rs * gv[bj][1]; }
                if (m & 1) asm volatile("" ::: "memory"); }
    }
};
struct EpiUp {
    static constexpr bool PERM = true, AFTER_DRAIN = false;
    const float* rowsq; bf16_t* up;
    __device__ __forceinline__ void operator()(const f32x4 (&acc)[2][2][4][2], const Unit& u, int wr, int wc, int fr, int fq) const {
        const int row0 = u.pm * BM + wr * 64 + fr, col0 = u.pn * BM + wc * 32 + 8 * fq;
        float rsv[2][4];
#pragma unroll
        for (int ai = 0; ai < 2; ++ai)
#pragma unroll
            for (int m = 0; m < 4; ++m) rsv[ai][m] = rowsq[row0 + ai * HALF + m * 16];
#pragma unroll
        for (int ai = 0; ai < 2; ++ai)
#pragma unroll
            for (int m = 0; m < 4; ++m) { const size_t row = row0 + ai * HALF + m * 16; const float rs = __builtin_amdgcn_rsqf(rsv[ai][m] * (1.0f / DM) + EPS);
#pragma unroll
                for (int bj = 0; bj < 2; ++bj) { f32x4 v0 = acc[ai][bj][m][0] * rs, v1 = acc[ai][bj][m][1] * rs;
                    v0 = __builtin_elementwise_max(v0, (f32x4){0.f, 0.f, 0.f, 0.f}); v1 = __builtin_elementwise_max(v1, (f32x4){0.f, 0.f, 0.f, 0.f});
                    v0 = v0 * v0; v1 = v1 * v1;
                    *(u32x4*)(up + row * FF + col0 + bj * HALF) = pack8(v0, v1); }
                asm volatile("" ::: "memory"); }
    }
};

template <class Epi, class Sched, bool ALIGN_EPI = false, bool SP2 = false>
__device__ __forceinline__ void gemm_phase(LAS unsigned char* lds, const Gemm g, const Sched& S, const Epi& E) {
    int tid_ = threadIdx.x; asm volatile("" : "+v"(tid_));
    const int tid = tid_, wid = __builtin_amdgcn_readfirstlane(tid >> 6), lane = tid & 63, wr = wid >> 2, wc = wid & 3, fr = lane & 15, fq = lane >> 4;
    const int K = g.K, nt = K / BK;
    unsigned voffA[2], voffB[2];
#pragma unroll
    for (int i = 0; i < 2; ++i) { int R, C; stage_rc(tid * 16 + i * 8192, R, C); const int Rb = Epi::PERM ? ((R & ~31) + perm32(R & 31)) : R;
        voffA[i] = (unsigned)(R * K + C) * 2u; voffB[i] = (unsigned)(Rb * K + C) * 2u; }
    const size_t kstep = (size_t)(BK * 2);
    const size_t hstep = (size_t)HALF * K * 2;
    const size_t tstep = 2 * hstep;
    const unsigned ldsw = (unsigned)wid * 1024u;
    const int aoff = lds_byte(wr * 64 + fr, fq * 8), boff = lds_byte(wc * 32 + fr, fq * 8);
#define PG8_SA(b, h) (((b) * 2 + (h)) * HTB)
#define PG8_SB(b, h) ((4 + (b) * 2 + (h)) * HTB)
#define PG8_STAGE(bufoff, gbase, voff) do { _Pragma("unroll") for (int _i = 0; _i < 2; ++_i) \
        __builtin_amdgcn_global_load_lds((const unsigned*)((const char*)(gbase) + (voff)[_i]), (LAS unsigned*)(lds + (bufoff) + ldsw + _i * 8192), 16, 0, 0); } while (0)
#define PG8_LDA(dst, b, h) do { _Pragma("unroll") for (int m = 0; m < 4; ++m) _Pragma("unroll") for (int k = 0; k < 2; ++k) dst[m][k] = *(const LAS bf16x8*)(lds + PG8_SA(b, h) + aoff + m * 2048 + k * 1024); } while (0)
#define PG8_LDB(dst, b, h) do { _Pragma("unroll") for (int n = 0; n < 2; ++n) _Pragma("unroll") for (int k = 0; k < 2; ++k) dst[n][k] = *(const LAS bf16x8*)(lds + PG8_SB(b, h) + boff + n * 2048 + k * 1024); } while (0)
#define PG8_MMA(ai, bj, At, Bt) do { __builtin_amdgcn_s_setprio(1); _Pragma("unroll") for (int m = 0; m < 4; ++m) _Pragma("unroll") for (int n = 0; n < 2; ++n) _Pragma("unroll") for (int k = 0; k < 2; ++k) \
        acc[ai][bj][m][n] = __builtin_amdgcn_mfma_f32_16x16x32_bf16(Bt[n][k], At[m][k], acc[ai][bj][m][n], 0, 0, 0); __builtin_amdgcn_s_setprio(0); } while (0)
#define PG8_WAIT_V(n) asm volatile("s_waitcnt vmcnt(" #n ")" ::: "memory")
#define PG8_WAIT_L(n) asm volatile("s_waitcnt lgkmcnt(" #n ")" ::: "memory")
#define PG8_BAR __builtin_amdgcn_s_barrier()
#define PG8_SCHED __builtin_amdgcn_sched_barrier(0)
    Unit cur, nxt; int ui = 0;
    if (!S.next(0, cur)) return;
    f32x4 acc[2][2][4][2];
#pragma unroll
    for (int a = 0; a < 2; ++a)
#pragma unroll
        for (int b = 0; b < 2; ++b)
#pragma unroll
            for (int m = 0; m < 4; ++m)
#pragma unroll
                for (int n = 0; n < 2; ++n) acc[a][b][m][n] = (f32x4){0.f, 0.f, 0.f, 0.f};
    bf16x8 At[4][2], B0[2][2], B1[2][2];
    const char* cA = (const char*)g.A + (size_t)cur.pm * tstep; const char* cB = (const char*)g.Bt + (size_t)cur.pn * tstep;
    S.a_ready(cur);
    if constexpr (SP2) {
        PG8_STAGE(PG8_SB(0, 0), cB, voffB); PG8_STAGE(PG8_SB(0, 1), cB + hstep, voffB); PG8_STAGE(PG8_SA(0, 0), cA, voffA); PG8_STAGE(PG8_SA(0, 1), cA + hstep, voffA);
        if (wr == 1) PG8_BAR;
        PG8_WAIT_V(2); PG8_BAR;
        PG8_STAGE(PG8_SB(1, 0), cB + kstep, voffB); PG8_STAGE(PG8_SA(1, 0), cA + kstep, voffA); PG8_STAGE(PG8_SB(1, 1), cB + hstep + kstep, voffB);
        PG8_WAIT_V(6); PG8_BAR;
    } else {
        PG8_STAGE(PG8_SB(0, 0), cB, voffB); PG8_STAGE(PG8_SA(0, 0), cA, voffA); PG8_STAGE(PG8_SB(0, 1), cB + hstep, voffB); PG8_STAGE(PG8_SA(0, 1), cA + hstep, voffA);
        if (wr == 1) PG8_BAR;
        PG8_WAIT_V(4); PG8_BAR;
        PG8_STAGE(PG8_SB(1, 0), cB + kstep, voffB); PG8_STAGE(PG8_SA(1, 0), cA + kstep, voffA); PG8_STAGE(PG8_SB(1, 1), cB + hstep + kstep, voffB);
        PG8_WAIT_V(6); PG8_BAR;
    }
    for (;;) {
        const bool has_next = S.next(ui + 1, nxt);
        const char* nA = has_next ? (const char*)g.A + (size_t)nxt.pm * tstep : cA; const char* nB = has_next ? (const char*)g.Bt + (size_t)nxt.pn * tstep : cB;
        for (int t = 0; t < nt; t += 2) {
            const bool last = (t == nt - 2);
            const char* a1 = cA + (size_t)(t + 1) * kstep;
            const char* a2 = last ? nA : cA + (size_t)(t + 2) * kstep; const char* b2 = last ? nB : cB + (size_t)(t + 2) * kstep;
            const char* a3 = a2 + kstep; const char* b3 = b2 + kstep;
            if (last && has_next) S.a_ready(nxt);
            if constexpr (SP2) {
            PG8_LDB(B0, 0, 0); PG8_LDB(B1, 0, 1); PG8_SCHED; PG8_LDA(At, 0, 0); PG8_STAGE(PG8_SA(1, 1), a1 + hstep, voffA);
            PG8_WAIT_V(8); PG8_WAIT_L(0); PG8_BAR; PG8_MMA(0, 0, At, B0); PG8_MMA(0, 1, At, B1); PG8_BAR; PG8_SCHED;
            PG8_LDA(At, 0, 1); PG8_STAGE(PG8_SB(0, 0), b2, voffB); PG8_STAGE(PG8_SB(0, 1), b2 + hstep, voffB); PG8_STAGE(PG8_SA(0, 0), a2, voffA);
            PG8_WAIT_V(8); PG8_WAIT_L(0); PG8_BAR; PG8_MMA(1, 0, At, B0); PG8_MMA(1, 1, At, B1); PG8_BAR; PG8_SCHED;
            PG8_LDB(B0, 1, 0); PG8_LDB(B1, 1, 1); PG8_SCHED; PG8_LDA(At, 1, 0); PG8_STAGE(PG8_SA(0, 1), a2 + hstep, voffA);
            PG8_WAIT_V(8); PG8_WAIT_L(0); PG8_BAR; PG8_MMA(0, 0, At, B0); PG8_MMA(0, 1, At, B1); PG8_BAR; PG8_SCHED;
            PG8_LDA(At, 1, 1); PG8_STAGE(PG8_SB(1, 0), b3, voffB); PG8_STAGE(PG8_SB(1, 1), b3 + hstep, voffB); PG8_STAGE(PG8_SA(1, 0), a3, voffA);
            PG8_WAIT_V(8); PG8_WAIT_L(0); PG8_BAR; PG8_MMA(1, 0, At, B0); PG8_MMA(1, 1, At, B1); PG8_BAR; PG8_SCHED;
            } else {
            PG8_LDB(B0, 0, 0); PG8_SCHED; PG8_LDA(At, 0, 0); PG8_STAGE(PG8_SA(1, 1), a1 + hstep, voffA);
            PG8_WAIT_L(8); PG8_BAR; PG8_WAIT_L(0); PG8_MMA(0, 0, At, B0); PG8_BAR; PG8_SCHED;
            PG8_LDB(B1, 0, 1); PG8_STAGE(PG8_SB(0, 0), b2, voffB);
            PG8_BAR; PG8_WAIT_L(0); PG8_MMA(0, 1, At, B1); PG8_BAR;
            PG8_LDA(At, 0, 1); PG8_STAGE(PG8_SA(0, 0), a2, voffA);
            PG8_BAR; PG8_WAIT_L(0); PG8_MMA(1, 0, At, B0); PG8_BAR; PG8_SCHED;
            PG8_STAGE(PG8_SB(0, 1), b2 + hstep, voffB);
            PG8_WAIT_V(6); PG8_BAR; PG8_MMA(1, 1, At, B1); PG8_BAR;
            PG8_LDB(B0, 1, 0); PG8_SCHED; PG8_LDA(At, 1, 0); PG8_STAGE(PG8_SA(0, 1), a2 + hstep, voffA);
            PG8_WAIT_L(8); PG8_BAR; PG8_WAIT_L(0); PG8_MMA(0, 0, At, B0); PG8_BAR; PG8_SCHED;
            PG8_LDB(B1, 1, 1); PG8_STAGE(PG8_SB(1, 0), b3, voffB);
            PG8_BAR; PG8_WAIT_L(0); PG8_MMA(0, 1, At, B1); PG8_BAR;
            PG8_LDA(At, 1, 1); PG8_STAGE(PG8_SA(1, 0), a3, voffA);
            PG8_BAR; PG8_WAIT_L(0); PG8_MMA(1, 0, At, B0); PG8_BAR; PG8_SCHED;
            PG8_STAGE(PG8_SB(1, 1), b3 + hstep, voffB);
            PG8_WAIT_V(6); PG8_BAR; PG8_MMA(1, 1, At, B1); PG8_BAR;
            }
        }
        if constexpr (ALIGN_EPI) { if (wr == 0) PG8_BAR; }
        if constexpr (!Epi::AFTER_DRAIN) { E(acc, cur, wr, wc, fr, fq); S.done(cur); }
        if (!has_next) break;
#pragma unroll
        for (int a = 0; a < 2; ++a)
#pragma unroll
            for (int b = 0; b < 2; ++b)
#pragma unroll
                for (int m = 0; m < 4; ++m)
#pragma unroll
                    for (int n = 0; n < 2; ++n) acc[a][b][m][n] = (f32x4){0.f, 0.f, 0.f, 0.f};
        cur = nxt; cA = nA; cB = nB; ++ui;
        if constexpr (ALIGN_EPI) { if (wr == 1) PG8_BAR; }
    }
    PG8_WAIT_V(0);
    if constexpr (!ALIGN_EPI) { if (wr == 0) PG8_BAR; }
    PG8_BAR;
#undef PG8_SA
#undef PG8_SB
#undef PG8_STAGE
#undef PG8_LDA
#undef PG8_LDB
#undef PG8_MMA
#undef PG8_WAIT_V
#undef PG8_WAIT_L
#undef PG8_BAR
#undef PG8_SCHED
}

template <class Mid, class Epi, class Sched>
__device__ __forceinline__ void gemm_phase_dual(LAS unsigned char* lds, const bf16_t* A1, const bf16_t* B1, int nt1, const bf16_t* A2, const bf16_t* B2, int nt2, int ld, const Sched& S, const Mid& Mh, const Epi& E) {
    int tid_ = threadIdx.x; asm volatile("" : "+v"(tid_));
    const int tid = tid_, wid = __builtin_amdgcn_readfirstlane(tid >> 6), lane = tid & 63, wr = wid >> 2, wc = wid & 3, fr = lane & 15, fq = lane >> 4;
    unsigned voffA[2], voffB[2];
#pragma unroll
    for (int i = 0; i < 2; ++i) { int R, C; stage_rc(tid * 16 + i * 8192, R, C); const int Rb = ((R & ~31) + perm32(R & 31));
        voffA[i] = (unsigned)(R * ld + C) * 2u; voffB[i] = (unsigned)(Rb * ld + C) * 2u; }
    const size_t kstep = (size_t)(BK * 2);
    const size_t hstep = (size_t)HALF * ld * 2;
    const size_t tstep = 2 * hstep;
    const unsigned ldsw = (unsigned)wid * 1024u;
    const int aoff = lds_byte(wr * 64 + fr, fq * 8), boff = lds_byte(wc * 32 + fr, fq * 8);
#define PG8_SA(b, h) (((b) * 2 + (h)) * HTB)
#define PG8_SB(b, h) ((4 + (b) * 2 + (h)) * HTB)
#define PG8_STAGE(bufoff, gbase, voff) do { _Pragma("unroll") for (int _i = 0; _i < 2; ++_i) \
        __builtin_amdgcn_global_load_lds((const unsigned*)((const char*)(gbase) + (voff)[_i]), (LAS unsigned*)(lds + (bufoff) + ldsw + _i * 8192), 16, 0, 0); } while (0)
#define PG8_LDA(dst, b, h) do { _Pragma("unroll") for (int m = 0; m < 4; ++m) _Pragma("unroll") for (int k = 0; k < 2; ++k) dst[m][k] = *(const LAS bf16x8*)(lds + PG8_SA(b, h) + aoff + m * 2048 + k * 1024); } while (0)
#define PG8_LDB(dst, b, h) do { _Pragma("unroll") for (int n = 0; n < 2; ++n) _Pragma("unroll") for (int k = 0; k < 2; ++k) dst[n][k] = *(const LAS bf16x8*)(lds + PG8_SB(b, h) + boff + n * 2048 + k * 1024); } while (0)
#define PG8_MMA(ai, bj, At, Bt) do { __builtin_amdgcn_s_setprio(1); _Pragma("unroll") for (int m = 0; m < 4; ++m) _Pragma("unroll") for (int n = 0; n < 2; ++n) _Pragma("unroll") for (int k = 0; k < 2; ++k) \
        acc[ai][bj][m][n] = __builtin_amdgcn_mfma_f32_16x16x32_bf16(Bt[n][k], At[m][k], acc[ai][bj][m][n], 0, 0, 0); __builtin_amdgcn_s_setprio(0); } while (0)
#define PG8_WAIT_V(n) asm volatile("s_waitcnt vmcnt(" #n ")" ::: "memory")
#define PG8_WAIT_L(n) asm volatile("s_waitcnt lgkmcnt(" #n ")" ::: "memory")
#define PG8_BAR __builtin_amdgcn_s_barrier()
#define PG8_SCHED __builtin_amdgcn_sched_barrier(0)
    Unit cur, nxt; int ui = 0, seg = 0;
    if (!S.next(0, cur)) return;
    f32x4 acc[2][2][4][2];
#pragma unroll
    for (int a = 0; a < 2; ++a)
#pragma unroll
        for (int b = 0; b < 2; ++b)
#pragma unroll
            for (int m = 0; m < 4; ++m)
#pragma unroll
                for (int n = 0; n < 2; ++n) acc[a][b][m][n] = (f32x4){0.f, 0.f, 0.f, 0.f};
    bf16x8 At[4][2], B0[2][2], B1f[2][2];
    const char* cA = (const char*)A1 + (size_t)cur.pm * tstep; const char* cB = (const char*)B1 + (size_t)cur.pn * tstep; int nt = nt1;
    PG8_STAGE(PG8_SB(0, 0), cB, voffB); PG8_STAGE(PG8_SB(0, 1), cB + hstep, voffB); PG8_STAGE(PG8_SA(0, 0), cA, voffA); PG8_STAGE(PG8_SA(0, 1), cA + hstep, voffA);
    if (wr == 1) PG8_BAR;
    PG8_WAIT_V(2); PG8_BAR;
    PG8_STAGE(PG8_SB(1, 0), cB + kstep, voffB); PG8_STAGE(PG8_SA(1, 0), cA + kstep, voffA); PG8_STAGE(PG8_SB(1, 1), cB + hstep + kstep, voffB);
    PG8_WAIT_V(6); PG8_BAR;
    for (;;) {
        bool has_next; const char* nA; const char* nB; int nnt;
        if (seg == 0) { has_next = true; nA = (const char*)A2 + (size_t)cur.pm * tstep; nB = (const char*)B2 + (size_t)cur.pn * tstep; nnt = nt2; }
        else { has_next = S.next(ui + 1, nxt); nA = has_next ? (const char*)A1 + (size_t)nxt.pm * tstep : cA; nB = has_next ? (const char*)B1 + (size_t)nxt.pn * tstep : cB; nnt = nt1; }
        for (int t = 0; t < nt; t += 2) {
            const bool last = (t == nt - 2);
            const char* a1 = cA + (size_t)(t + 1) * kstep;
            const char* a2 = last ? nA : cA + (size_t)(t + 2) * kstep; const char* b2 = last ? nB : cB + (size_t)(t + 2) * kstep;
            const char* a3 = a2 + kstep; const char* b3 = b2 + kstep;
            PG8_LDB(B0, 0, 0); PG8_LDB(B1f, 0, 1); PG8_SCHED; PG8_LDA(At, 0, 0); PG8_STAGE(PG8_SA(1, 1), a1 + hstep, voffA);
            PG8_WAIT_V(8); PG8_WAIT_L(0); PG8_BAR; PG8_MMA(0, 0, At, B0); PG8_MMA(0, 1, At, B1f); PG8_BAR; PG8_SCHED;
            PG8_LDA(At, 0, 1); PG8_STAGE(PG8_SB(0, 0), b2, voffB); PG8_STAGE(PG8_SB(0, 1), b2 + hstep, voffB); PG8_STAGE(PG8_SA(0, 0), a2, voffA);
            PG8_WAIT_V(8); PG8_WAIT_L(0); PG8_BAR; PG8_MMA(1, 0, At, B0); PG8_MMA(1, 1, At, B1f); PG8_BAR; PG8_SCHED;
            PG8_LDB(B0, 1, 0); PG8_LDB(B1f, 1, 1); PG8_SCHED; PG8_LDA(At, 1, 0); PG8_STAGE(PG8_SA(0, 1), a2 + hstep, voffA);
            PG8_WAIT_V(8); PG8_WAIT_L(0); PG8_BAR; PG8_MMA(0, 0, At, B0); PG8_MMA(0, 1, At, B1f); PG8_BAR; PG8_SCHED;
            PG8_LDA(At, 1, 1); PG8_STAGE(PG8_SB(1, 0), b3, voffB); PG8_STAGE(PG8_SB(1, 1), b3 + hstep, voffB); PG8_STAGE(PG8_SA(1, 0), a3, voffA);
            PG8_WAIT_V(8); PG8_WAIT_L(0); PG8_BAR; PG8_MMA(1, 0, At, B0); PG8_MMA(1, 1, At, B1f); PG8_BAR; PG8_SCHED;
        }
        if (wr == 0) PG8_BAR;
        if (seg == 0) Mh(acc, cur, wr, wc, fr, fq); else E(acc, cur, wr, wc, fr, fq);
        if (seg == 1 && !has_next) break;
        if (seg == 1) {
#pragma unroll
            for (int a = 0; a < 2; ++a)
#pragma unroll
                for (int b = 0; b < 2; ++b)
#pragma unroll
                    for (int m = 0; m < 4; ++m)
#pragma unroll
                        for (int n = 0; n < 2; ++n) acc[a][b][m][n] = (f32x4){0.f, 0.f, 0.f, 0.f};
            cur = nxt; ++ui; }
        cA = nA; cB = nB; nt = nnt; seg ^= 1;
        if (wr == 1) PG8_BAR;
    }
    PG8_WAIT_V(0);
    PG8_BAR;
#undef PG8_SA
#undef PG8_SB
#undef PG8_STAGE
#undef PG8_LDA
#undef PG8_LDB
#undef PG8_MMA
#undef PG8_WAIT_V
#undef PG8_WAIT_L
#undef PG8_BAR
#undef PG8_SCHED
}
}
using pg8::cvt_pk_bf16;

__device__ __forceinline__ float wave_sum(float v) {
#pragma unroll
    for (int o = 1; o < 64; o <<= 1) v += __shfl_xor(v, o);
    return v;
}
__device__ __forceinline__ s16x4 vtr(LAS const unsigned char* p) { return __builtin_bit_cast(s16x4, __builtin_amdgcn_ds_read_tr16_b64_v4i16((LAS s16x4*)p)); }

__device__ __forceinline__ void p0_transpose_item(const float* W, int K, int N, bf16_t* WT, const float* gk, LAS float* scr, int item, int lane, int ldw = 0) {
    if (ldw == 0) ldw = K;
    const int nblk = N / 32, kb = item / nblk, nb = item % nblk, k0 = 64 * kb, n0 = 32 * nb;
#pragma unroll
    for (int i = 0; i < 32; ++i) { const int kk = 2 * i + (lane >> 5); float w = W[(size_t)(k0 + kk) * N + n0 + (lane & 31)]; if (gk) w *= gk[k0 + kk]; scr[kk * 33 + (lane & 31)] = w; }
    asm volatile("s_waitcnt lgkmcnt(0)" ::: "memory");
    const int c = lane & 7;
#pragma unroll
    for (int j = 0; j < 4; ++j) { const int n = (lane >> 3) + 8 * j; const LAS float* s = scr + (8 * c) * 33 + n;
        u32x4 o; o.x = cvt_pk_bf16(s[0 * 33], s[1 * 33]); o.y = cvt_pk_bf16(s[2 * 33], s[3 * 33]); o.z = cvt_pk_bf16(s[4 * 33], s[5 * 33]); o.w = cvt_pk_bf16(s[6 * 33], s[7 * 33]);
        *(u32x4*)(WT + (size_t)(n0 + n) * ldw + k0 + 8 * c) = o; }
    asm volatile("s_waitcnt lgkmcnt(0)" ::: "memory");
}
__device__ __forceinline__ void hprep_rows(const float* x, bf16_t* h, int gw, int ngw, int lane) {
    for (int m = gw; m < MC / 2; m += ngw) {
        const f32x4* xa = (const f32x4*)(x + (size_t)m * DM) + lane; const f32x4* xb = (const f32x4*)(x + (size_t)(m + MC / 2) * DM) + lane;
        f32x4 va[4], vb[4]; float sa = 0.f, sb = 0.f;
#pragma unroll
        for (int j = 0; j < 4; ++j) { va[j] = xa[64 * j]; vb[j] = xb[64 * j]; }
#pragma unroll
        for (int j = 0; j < 4; ++j) { sa += pg8::dot4(va[j]); sb += pg8::dot4(vb[j]); }
        const float ra = __builtin_amdgcn_rsqf(wave_sum(sa) * (1.0f / DM) + EPS), rb = __builtin_amdgcn_rsqf(wave_sum(sb) * (1.0f / DM) + EPS);
        u32x2* oa = (u32x2*)(h + (size_t)m * DM) + lane; u32x2* ob = (u32x2*)(h + (size_t)(m + MC / 2) * DM) + lane;
#pragma unroll
        for (int j = 0; j < 4; ++j) { u32x2 w; w.x = cvt_pk_bf16(va[j][0] * ra, va[j][1] * ra); w.y = cvt_pk_bf16(va[j][2] * ra, va[j][3] * ra); oa[64 * j] = w;
            u32x2 z; z.x = cvt_pk_bf16(vb[j][0] * rb, vb[j][1] * rb); z.y = cvt_pk_bf16(vb[j][2] * rb, vb[j][3] * rb); ob[64 * j] = z; }
    }
}
__device__ __forceinline__ void final_norm_rows(float* xo, const float* rowsq, const float* gfin, int gw, int ngw, int lane) {
    f32x4 gv[4];
#pragma unroll
    for (int j = 0; j < 4; ++j) gv[j] = ((const f32x4*)gfin)[lane + 64 * j];
    for (int m = gw; m < MC / 2; m += ngw) {
        f32x4* xa = (f32x4*)(xo + (size_t)m * DM) + lane; f32x4* xb = (f32x4*)(xo + (size_t)(m + MC / 2) * DM) + lane;
        const float qa = rowsq[m], qb = rowsq[m + MC / 2];
        f32x4 va[4], vb[4];
#pragma unroll
        for (int j = 0; j < 4; ++j) { va[j] = xa[64 * j]; vb[j] = xb[64 * j]; }
        const float ra = __builtin_amdgcn_rsqf(qa * (1.0f / DM) + EPS), rb = __builtin_amdgcn_rsqf(qb * (1.0f / DM) + EPS);
#pragma unroll
        for (int j = 0; j < 4; ++j) { xa[64 * j] = va[j] * ra * gv[j]; xb[64 * j] = vb[j] * rb * gv[j]; }
    }
}

__device__ __forceinline__ void att_dma16(const void* g, LAS void* l) {
    asm volatile("s_mov_b32 m0, %0\n\ts_nop 0\n\tglobal_load_lds_dwordx4 %1, off" :: "s"((unsigned)(size_t)l), "v"(g) : "memory", "m0");
}
struct AUnit { int g, hj, seq, r, m0, dsh, L; };
__device__ __forceinline__ void attn_decode(int uid, bool combine, int S, AUnit& u) {
    int rem; if (combine) { u.g = 0; rem = uid; } else { u.g = 1 + (uid >> 11); rem = uid & 2047; }
    u.hj = rem & 7; const int blk = rem >> 3;
    u.dsh = 2 * u.g;
    const int lgb = (S == 4096) ? 5 : 6;
    u.seq = blk >> lgb; const int bs = blk & ((1 << lgb) - 1);
    u.L = S >> u.dsh; const int lgr = lgb - u.dsh;
    u.r = bs >> lgr; u.m0 = (bs & ((1 << lgr) - 1)) << 7;
}
template <bool COMBINE>
__device__ __forceinline__ void attn_phase(LAS unsigned char* lds, const bf16_t* qkv, int S, bf16_t* po, float* ps, bf16_t* attn, int vcu, int G, int tid, int lane, int wave) {
    const int nunits = COMBINE ? 2048 : 4096;
    const int fr = lane & 15, fq = lane >> 4;
    bf16x8 qn0, qn1;
    int uid = vcu; if (uid >= nunits) return;
    AUnit cur; attn_decode(uid, COMBINE, S, cur);
#define ATT_STAGE(U, B) do { _Pragma("unroll") for (int i = 0; i < 4; ++i) { const int seg = wave * 4 + i, row = seg * 8 + (lane >> 3), cp = lane & 7; const int mm = (U).m0 - 64 + row; \
        const bool ok = (mm >= 0) && (mm < (U).L); const size_t grow = (size_t)(U).seq * S + ((size_t)(ok ? mm : 0) << (U).dsh) + (U).r; \
        const bf16_t* p = qkv + ((size_t)(24 + (U).g * 8 + (U).hj) * MC + grow) * 64; \
        const int chk = cp ^ (row & 7), chv = cp ^ ((((row >> 1) & 1) << 1) | (((row >> 2) & 1) << 2)); \
        att_dma16(p + chk * 8, lds + (B) * 65536 + seg * 1024); \
        att_dma16(p + (size_t)24 * MC * 64 + chv * 8, lds + (B) * 65536 + 32768 + seg * 1024); } \
        { const int mq_ = (U).m0 + 16 * wave + fr; const size_t rq_ = (size_t)(U).seq * S + ((size_t)mq_ << (U).dsh) + (U).r; \
          const bf16_t* qp_ = qkv + ((size_t)((U).g * 8 + (U).hj) * MC + rq_) * 64 + 8 * fq; qn0 = *(const bf16x8*)qp_; qn1 = *(const bf16x8*)(qp_ + 32); } } while (0)
    int buf = 0;
    ATT_STAGE(cur, 0);
    asm volatile("s_waitcnt vmcnt(0)" ::: "memory");
    for (;;) {
        asm volatile("s_waitcnt vmcnt(4)" ::: "memory");
        __syncthreads();
        LAS unsigned char* kimg = lds + buf * 65536; LAS unsigned char* vimg = kimg + 32768;
        const int mq = cur.m0 + 16 * wave + fr;
        const size_t rowq = (size_t)cur.seq * S + ((size_t)mq << cur.dsh) + cur.r;
        const bf16x8 qf0 = qn0, qf1 = qn1;
        f32x2 s1, s2; u32x2 pa[4], pb[4];
        if constexpr (COMBINE) {
            s1 = *(const f32x2*)(ps + (rowq * 8 + cur.hj) * 2); s2 = *(const f32x2*)(ps + (((size_t)MC + rowq) * 8 + cur.hj) * 2);
            const bf16_t* p1 = po + rowq * AO + cur.hj * 64 + 4 * fq; const bf16_t* p2 = p1 + (size_t)MC * AO;
#pragma unroll
            for (int dt = 0; dt < 4; ++dt) { pa[dt] = *(const u32x2*)(p1 + 16 * dt); pb[dt] = *(const u32x2*)(p2 + 16 * dt); }
        }
        const int nuid = uid + G; const bool hn = nuid < nunits;
        if (hn) { AUnit nxt; attn_decode(nuid, COMBINE, S, nxt); ATT_STAGE(nxt, buf ^ 1); }
        __builtin_amdgcn_sched_barrier(0);
        f32x4 st[9];
        { const int sw = fr & 7; const LAS unsigned char* kb = kimg + (16 * wave + fr) * 128; const int o0 = (fq ^ sw) << 4, o1 = ((4 + fq) ^ sw) << 4;
#pragma unroll
          for (int j = 0; j < 9; ++j) { const bf16x8 k0 = *(const LAS bf16x8*)(kb + j * 2048 + o0), k1 = *(const LAS bf16x8*)(kb + j * 2048 + o1);
              f32x4 z = (f32x4){0.f, 0.f, 0.f, 0.f};
              z = __builtin_amdgcn_mfma_f32_16x16x32_bf16(k0, qf0, z, 0, 0, 0); st[j] = __builtin_amdgcn_mfma_f32_16x16x32_bf16(k1, qf1, z, 0, 0, 0);
              if (j % 3 == 2) __builtin_amdgcn_sched_barrier(0); } }
        const float slope = __builtin_amdgcn_exp2f(-(float)(cur.g * 8 + cur.hj + 1) * (8.0f / 24.0f));
        const float c2 = slope * (float)(1 << cur.dsh) * LOG2E, sc2 = 0.125f * LOG2E;
        float mx = -3.0e38f; float pv[9][4];
        { const int d0 = 4 * fq - fr; const float c2d = c2 * (float)d0; const int klo = cur.m0 + 16 * wave - 64;
#pragma unroll
          for (int j = 0; j < 9; ++j) {
#pragma unroll
              for (int e = 0; e < 4; ++e) { const float t = c2 * (float)(16 * j - 64 + e) + c2d;
                  float s;
                  if (j <= 3) s = st[j][e] * sc2 + t; else if (j >= 5) s = st[j][e] * sc2 - t; else s = st[j][e] * sc2 - __builtin_fabsf(t);
                  if (j == 0) s = (d0 + e < 0) ? -1.0e30f : s;
                  if (j == 8) s = (d0 + e > 0) ? -1.0e30f : s;
                  pv[j][e] = s; }
              const int lo = klo + 16 * j;
              if (lo < 0 || lo + 16 > cur.L) {
#pragma unroll
                  for (int e = 0; e < 4; ++e) { const int mk = lo + 4 * fq + e; pv[j][e] = ((unsigned)mk < (unsigned)cur.L) ? pv[j][e] : -1.0e30f; } }
#pragma unroll
              for (int e = 0; e < 4; ++e) mx = fmaxf(mx, pv[j][e]); } }
        mx = fmaxf(mx, __shfl_xor(mx, 16)); mx = fmaxf(mx, __shfl_xor(mx, 32));
        float lsum = 0.f;
#pragma unroll
        for (int j = 0; j < 9; ++j)
#pragma unroll
            for (int e = 0; e < 4; ++e) { const float p = __builtin_amdgcn_exp2f(pv[j][e] - mx); pv[j][e] = p; lsum += p; }
        lsum += __shfl_xor(lsum, 16); lsum += __shfl_xor(lsum, 32);
        __builtin_amdgcn_sched_barrier(0);
        f32x4 o[4];
#pragma unroll
        for (int dt = 0; dt < 4; ++dt) o[dt] = (f32x4){0.f, 0.f, 0.f, 0.f};
        { const int q = fr >> 2, p = fr & 3; const int fs = ((q >> 1) & 1) | ((fq & 1) << 1);
          const LAS unsigned char* vb = vimg + (16 * wave + 4 * fq + q) * 128 + p * 8;
          int vo[4];
#pragma unroll
          for (int dt = 0; dt < 4; ++dt) vo[dt] = (dt ^ fs) << 5;
#pragma unroll
          for (int kk = 0; kk < 5; ++kk) {
              u32x4 pw; pw.x = cvt_pk_bf16(pv[2 * kk][0], pv[2 * kk][1]); pw.y = cvt_pk_bf16(pv[2 * kk][2], pv[2 * kk][3]);
              if (kk < 4) { pw.z = cvt_pk_bf16(pv[2 * kk + 1 < 9 ? 2 * kk + 1 : 8][0], pv[2 * kk + 1 < 9 ? 2 * kk + 1 : 8][1]); pw.w = cvt_pk_bf16(pv[2 * kk + 1 < 9 ? 2 * kk + 1 : 8][2], pv[2 * kk + 1 < 9 ? 2 * kk + 1 : 8][3]); }
              else { pw.z = 0u; pw.w = 0u; }
              const bf16x8 pf = __builtin_bit_cast(bf16x8, pw);
              const int T0 = 2 * kk, T1 = (2 * kk + 1 < 9) ? 2 * kk + 1 : 8;
#pragma unroll
              for (int dt = 0; dt < 4; ++dt) { const s16x4 a = vtr(vb + T0 * 2048 + vo[dt]), b = vtr(vb + T1 * 2048 + vo[dt]);
                  const bf16x8 vf = __builtin_shufflevector(a, b, 0, 1, 2, 3, 4, 5, 6, 7);
                  o[dt] = __builtin_amdgcn_mfma_f32_16x16x32_bf16(vf, pf, o[dt], 0, 0, 0); }
              __builtin_amdgcn_sched_barrier(0); } }
        if constexpr (!COMBINE) {
            const float inv = 1.0f / lsum; const size_t prow = (size_t)(cur.g - 1) * MC + rowq;
            bf16_t* op = po + prow * AO + cur.hj * 64 + 4 * fq;
#pragma unroll
            for (int dt = 0; dt < 4; ++dt) { u32x2 w; w.x = cvt_pk_bf16(o[dt][0] * inv, o[dt][1] * inv); w.y = cvt_pk_bf16(o[dt][2] * inv, o[dt][3] * inv); *(u32x2*)(op + 16 * dt) = w; }
            if (fq == 0) *(f32x2*)(ps + (prow * 8 + cur.hj) * 2) = (f32x2){mx, lsum};
        } else {
            const float Mx = fmaxf(mx, fmaxf(s1.x, s2.x));
            const float e0 = __builtin_amdgcn_exp2f(mx - Mx), w1 = s1.y * __builtin_amdgcn_exp2f(s1.x - Mx), w2 = s2.y * __builtin_amdgcn_exp2f(s2.x - Mx);
            const float invW = 1.0f / (lsum * e0 + w1 + w2);
            bf16_t* op = attn + rowq * DM + cur.hj * 64 + 4 * fq;
#pragma unroll
            for (int dt = 0; dt < 4; ++dt) { const u32x2 a = pa[dt], b = pb[dt];
                const float r0 = (o[dt][0] * e0 + w1 * pg8::bf_lo(a.x) + w2 * pg8::bf_lo(b.x)) * invW, r1 = (o[dt][1] * e0 + w1 * pg8::bf_hi(a.x) + w2 * pg8::bf_hi(b.x)) * invW;
                const float r2 = (o[dt][2] * e0 + w1 * pg8::bf_lo(a.y) + w2 * pg8::bf_lo(b.y)) * invW, r3 = (o[dt][3] * e0 + w1 * pg8::bf_hi(a.y) + w2 * pg8::bf_hi(b.y)) * invW;
                u32x2 w; w.x = cvt_pk_bf16(r0, r1); w.y = cvt_pk_bf16(r2, r3); *(u32x2*)(op + 16 * dt) = w; }
        }
        if (!hn) break;
        uid = nuid; attn_decode(uid, COMBINE, S, cur); buf ^= 1;
    }
#undef ATT_STAGE
    asm volatile("s_waitcnt vmcnt(0)" ::: "memory");
    __syncthreads();
}

__device__ __forceinline__ void sgu_phase(LAS unsigned char* lds, const bf16_t* uv, const float* rowsq, const float* w_s, const float* b_s, const float* g_sgu, bf16_t* sgu,
                                          int vcu, int G, int tid, int lane, int wave) {
    const int nunits = 2048; const int fr = lane & 15, fq = lane >> 4;
    LAS float* rsl = (LAS float*)(lds + 32768);
    u32x4 vreg[4];
    int uid = vcu; if (uid >= nunits) return;
#define SGU_PREFETCH(UID) do { const int cgp_ = (UID) & 7, pc_ = (UID) >> 3; _Pragma("unroll") for (int i = 0; i < 4; ++i) { const int idx = tid + 512 * i, row = idx >> 4, ch = idx & 15; \
        vreg[i] = *(const u32x4*)(uv + (size_t)(pc_ * 128 + row) * UV_W + 1024 + cgp_ * 128 + ch * 8); } } while (0)
    SGU_PREFETCH(uid);
    for (;;) {
        const int cgp = uid & 7, pc = uid >> 3;
        __syncthreads();
#pragma unroll
        for (int i = 0; i < 4; ++i) { const int idx = tid + 512 * i, row = idx >> 4, ch = idx & 15;
            *(LAS u32x4*)(lds + 256 * row + 16 * (ch ^ (((row & 3) << 2) | ((row >> 2) & 3)))) = vreg[i]; }
        if (tid < 128) rsl[tid] = __builtin_amdgcn_rsqf(rowsq[pc * 128 + tid] * (1.0f / DM) + EPS);
        __syncthreads();
        const int nuid = uid + G; const bool hn = nuid < nunits;
        if (hn) SGU_PREFETCH(nuid);
        f32x4 acc[8];
#pragma unroll
        for (int ct = 0; ct < 8; ++ct) acc[ct] = (f32x4){0.f, 0.f, 0.f, 0.f};
        const float* wrow = w_s + ((size_t)cgp * 128 + 16 * wave + fr) * 128 + 8 * fq;
        const int q = fr >> 2, p = fr & 3;
#pragma unroll
        for (int ks = 0; ks < 4; ++ks) {
            const f32x4 w0 = *(const f32x4*)(wrow + 32 * ks), w1 = *(const f32x4*)(wrow + 32 * ks + 4);
            const f32x4 r0 = *(const LAS f32x4*)(rsl + 32 * ks + 8 * fq), r1 = *(const LAS f32x4*)(rsl + 32 * ks + 8 * fq + 4);
            const bf16x8 wf = __builtin_bit_cast(bf16x8, pg8::pack8(w0 * r0, w1 * r1));
            const int ra = 32 * ks + 8 * fq + q, rb = ra + 4;
            const int xa = ((ra & 3) << 2) | ((ra >> 2) & 3), xb = ((rb & 3) << 2) | ((rb >> 2) & 3);
#pragma unroll
            for (int ct = 0; ct < 8; ++ct) { const int ch = 2 * ct + (p >> 1);
                const s16x4 a = vtr(lds + 256 * ra + 16 * (ch ^ xa) + 8 * (p & 1)), b = vtr(lds + 256 * rb + 16 * (ch ^ xb) + 8 * (p & 1));
                const bf16x8 vf = __builtin_shufflevector(a, b, 0, 1, 2, 3, 4, 5, 6, 7);
                acc[ct] = __builtin_amdgcn_mfma_f32_16x16x32_bf16(vf, wf, acc[ct], 0, 0, 0); } }
        const int t = 16 * wave + fr; const size_t row = (size_t)pc * 128 + t; const float bt = b_s[cgp * 128 + t];
#pragma unroll
        for (int ct = 0; ct < 8; ++ct) { const int c0 = cgp * 128 + 16 * ct + 4 * fq;
            const f32x4 gv = *(const f32x4*)(g_sgu + c0); const u32x2 uw = *(const u32x2*)(uv + row * UV_W + c0);
            const f32x4 mixed = acc[ct] * gv + bt;
            const f32x4 uu = (f32x4){pg8::bf_lo(uw.x), pg8::bf_hi(uw.x), pg8::bf_lo(uw.y), pg8::bf_hi(uw.y)};
            const f32x4 ov = uu * mixed; u32x2 w; w.x = cvt_pk_bf16(ov[0], ov[1]); w.y = cvt_pk_bf16(ov[2], ov[3]);
            *(u32x2*)(sgu + row * DM + c0) = w; }
        if (!hn) break;
        uid = nuid;
    }
#undef SGU_PREFETCH
    __syncthreads();
}


#define XB_TMO      128
#define XB_XCNT(j)  (256  + 64 * (j))
#define XB_XSUB(j)  (1280 + 64 * (j))
#define XB_XGEN(j)  (2304 + 64 * (j))
#define XB_TOP      3328
#define XB_TOPGEN   3392
#define XCD_BAR_WORDS 3456
#define XB_SPIN_CAP (1u << 22)
__device__ __forceinline__ unsigned xb_ld(unsigned* p)              { return __hip_atomic_load(p, __ATOMIC_RELAXED, __HIP_MEMORY_SCOPE_AGENT); }
__device__ __forceinline__ unsigned xb_add(unsigned* p, unsigned v) { return __hip_atomic_fetch_add(p, v, __ATOMIC_RELAXED, __HIP_MEMORY_SCOPE_AGENT); }
__device__ __forceinline__ unsigned xb_xcc_id() { return (unsigned)__builtin_amdgcn_s_getreg((3 << 11) | 20) & 0xFu; }
#define XB_SPIN(cond, bar) do { unsigned _sp = 0; while (cond) { __builtin_amdgcn_s_sleep(1); \
    if ((++_sp & 255u) == 0u) { if (xb_ld(&(bar)[XB_TMO])) break; if (_sp > XB_SPIN_CAP) { atomicAdd(&(bar)[XB_TMO], 1u); break; } } } } while (0)
struct XcdBarrier { unsigned* bar; unsigned x; volatile LAS unsigned* st; };
__device__ __forceinline__ XcdBarrier xcd_barrier_post(unsigned* bar, volatile LAS unsigned* st) {
    XcdBarrier b; b.bar = bar; b.x = xb_xcc_id(); b.st = st;
    if (threadIdx.x == 0) (void)xb_add(&bar[XB_XCNT(b.x)], 1u);
    return b;
}
__device__ __forceinline__ void xcd_barrier_complete(unsigned* bar, unsigned x, unsigned& nloc, unsigned& nx) {
    const unsigned G = gridDim.x * gridDim.y * gridDim.z;
    unsigned sum, cnt, mine, sp = 0u;
    for (;;) {
        sum = 0u; cnt = 0u; mine = 0u;
#pragma unroll
        for (unsigned j = 0; j < 16; ++j) { const unsigned c = xb_ld(&bar[XB_XCNT(j)]); sum += c; cnt += (c > 0u) ? 1u : 0u; mine = (j == x) ? c : mine; }
        if (sum == G) break;
        __builtin_amdgcn_s_sleep(1);
        if ((++sp & 255u) == 0u) { if (xb_ld(&bar[XB_TMO])) break; if (sp > XB_SPIN_CAP) { atomicAdd(&bar[XB_TMO], 1u); break; } }
    }
    nloc = mine > 0u ? mine : 1u; nx = cnt > 0u ? cnt : 1u;
}
__device__ __forceinline__ void xcd_barrier(const XcdBarrier& b) {
    asm volatile("s_waitcnt vmcnt(0)" ::: "memory");
    __syncthreads();
    if (threadIdx.x == 0) {
        unsigned* bar = b.bar;
        __builtin_amdgcn_s_waitcnt(0);
        unsigned nloc = b.st[0], nx = b.st[1];
        if (nloc == 0u) { xcd_barrier_complete(bar, b.x, nloc, nx); b.st[0] = nloc; b.st[1] = nx; }
        const unsigned old = xb_add(&bar[XB_XSUB(b.x)], 1u);
        const unsigned gen = old / nloc;
        if (old + 1u == (gen + 1u) * nloc) {
            __builtin_amdgcn_fence(__ATOMIC_RELEASE, "agent");
            asm volatile("s_waitcnt vmcnt(0)" ::: "memory");
            const unsigned og = xb_add(&bar[XB_TOP], 1u);
            const unsigned tg = og / nx;
            if (og + 1u == (tg + 1u) * nx) xb_add(&bar[XB_TOPGEN], 1u);
            else XB_SPIN(xb_ld(&bar[XB_TOPGEN]) == tg, bar);
            __builtin_amdgcn_fence(__ATOMIC_ACQUIRE, "agent");
            xb_add(&bar[XB_XGEN(b.x)], 1u);
            asm volatile("s_waitcnt vmcnt(0)" ::: "memory");
        } else {
            XB_SPIN(xb_ld(&bar[XB_XGEN(b.x)]) == gen, bar);
            __builtin_amdgcn_fence(__ATOMIC_ACQUIRE, "agent");
            asm volatile("s_waitcnt vmcnt(0)" ::: "memory");
        }
    }
    __syncthreads();
}

struct Args { const float* in[14]; float* out; unsigned char* ws; int ph_lo, ph_hi; };
constexpr int N_PHASES = 22;

__global__ void __launch_bounds__(512, 2) mega_fwd(Args a) {
    extern __shared__ __attribute__((aligned(16))) unsigned char lds_raw[];
    LAS unsigned char* lds = (LAS unsigned char*)lds_raw;
    cg::grid_group grid = cg::this_grid();
    const int G = gridDim.x, bx = blockIdx.x;
    const int vcu = (G % 8 == 0) ? (bx % 8) * (G / 8) + bx / 8 : bx;
    volatile LAS unsigned* misc = (volatile LAS unsigned*)(lds + LDS_MISC_OFF);
    if (threadIdx.x < 2) misc[threadIdx.x] = 0u;
    __syncthreads();
    const XcdBarrier xbar = xcd_barrier_post((unsigned*)(a.ws + WS_BAR), misc);
    grid.sync();
#define WSP(T, off) ((T*)(ws + (off)))
    for (int ph = a.ph_lo; ph < a.ph_hi; ++ph) {
        if (ph != a.ph_lo) xcd_barrier(xbar);
        size_t zoff = 0; asm volatile("" : "+s"(zoff)); unsigned char* ws = a.ws + zoff;
        int tid = threadIdx.x; asm volatile("" : "+v"(tid));
        const int lane = tid & 63, wave = __builtin_amdgcn_readfirstlane(tid >> 6);
        const int gw = vcu * 8 + wave, ngw = G * 8;
        if (ph == 0) {
            LAS float* scr = (LAS float*)(lds + wave * 16384);
            constexpr int I_IN = (DM / 64) * (IN_COLS / 32), I_A = (AO / 64) * (DM / 32), I_B = (DM / 64) * (DM / 32), I_O = I_B, I_UP = (DM / 64) * (FF / 32), I_DN = (FF / 64) * (DM / 32);
            constexpr int NITEMS = I_IN + I_A + I_B + I_O + I_UP + I_DN;
            for (int it = gw; it < I_IN; it += ngw) p0_transpose_item(a.in[3], DM, IN_COLS, WSP(bf16_t, WS_WIN), a.in[2], scr, it, lane);
            hprep_rows(a.in[0], WSP(bf16_t, WS_H), gw, ngw, lane);
            for (int i = gw * 64 + lane; i < (int)(CTL_BYTES / 16); i += ngw * 64) WSP(f32x4, WS_CTL)[i] = (f32x4){0.f, 0.f, 0.f, 0.f};
            continue;
        }
        const int c = (ph - 1) / 7, k = (ph - 1) % 7;
        const float* xin = (c < 2) ? a.in[0] + (size_t)c * MC * DM : a.in[1];
        float* xout = a.out + (size_t)c * MC * DM;
        const int S = (c < 2) ? 4096 : 8192;
        float* rsqv = WSP(float, OFF_RSQV) + c * MC; float* rsq1 = WSP(float, OFF_RSQ1) + c * MC; float* rsq2 = WSP(float, OFF_RSQ2) + c * MC;
        if (k == 0) {
            pg8::Gemm g{WSP(bf16_t, WS_H), WSP(bf16_t, WS_WIN), MC, IN_COLS, DM}; pg8::StaticOrder So; So.init(MC, IN_COLS, G, bx);
            pg8::EpiProj E{WSP(bf16_t, WS_QKV), WSP(bf16_t, WS_UV), WSP(bf16_t, WS_GG), rsqv};
            pg8::gemm_phase<pg8::EpiProj, pg8::StaticOrder, true, true>(lds, g, So, E);
        } else if (k == 1) {
            if (c == 0) {
                LAS float* scr = (LAS float*)(lds + wave * 16384);
                constexpr int I_A = (AO / 64) * (DM / 32), I_B = (DM / 64) * (DM / 32), I_O = I_B, I_UP = (DM / 64) * (FF / 32), I_DN = (FF / 64) * (DM / 32);
                for (int it = gw; it < I_A + I_B + I_O + I_UP + I_DN; it += ngw) {
                    int r = it;
                    if (r < I_A) { p0_transpose_item(a.in[7], AO, DM, WSP(bf16_t, WS_WA), nullptr, scr, r, lane, DM); continue; } r -= I_A;
                    if (r < I_B) { p0_transpose_item(a.in[8], DM, DM, WSP(bf16_t, WS_WB), nullptr, scr, r, lane); continue; } r -= I_B;
                    if (r < I_O) { p0_transpose_item(a.in[9], DM, DM, WSP(bf16_t, WS_WO), nullptr, scr, r, lane); continue; } r -= I_O;
                    if (r < I_UP) { p0_transpose_item(a.in[11], DM, FF, WSP(bf16_t, WS_WUP), a.in[10], scr, r, lane); continue; } r -= I_UP;
                    p0_transpose_item(a.in[12], FF, DM, WSP(bf16_t, WS_WDN), nullptr, scr, r, lane);
                }
                __syncthreads();
            }
            if (!(EXP_SKIP_MIX & 1)) attn_phase<false>(lds, WSP(bf16_t, WS_QKV), S, WSP(bf16_t, WS_PO), WSP(float, WS_PS), WSP(bf16_t, WS_ATTN), vcu, G, tid, lane, wave);
            if (c + 1 < NCHUNK) { const float* xn = (c + 1 < 2) ? a.in[0] + (size_t)(c + 1) * MC * DM : a.in[1]; hprep_rows(xn, WSP(bf16_t, WS_H), gw, ngw, lane); }
        } else if (k == 2) {
            if (EXP_SKIP_MIX & 1) { for (size_t i = (size_t)gw * 64 + lane; i < (size_t)MC * AO / 8; i += (size_t)ngw * 64) WSP(u32x4, WS_ATTN)[i] = (EXP_SKIP_MIX & 4) ? *(const u32x4*)(WSP(bf16_t, WS_QKV) + (i >> 6) * QKV_W + (i & 63) * 8) : (u32x4){0u, 0u, 0u, 0u}; }
            else attn_phase<true>(lds, WSP(bf16_t, WS_QKV), S, WSP(bf16_t, WS_PO), WSP(float, WS_PS), WSP(bf16_t, WS_ATTN), vcu, G, tid, lane, wave);
            if (EXP_SKIP_MIX & 2) { for (size_t i = (size_t)gw * 64 + lane; i < (size_t)MC * DM / 8; i += (size_t)ngw * 64) WSP(u32x4, WS_SGU)[i] = (EXP_SKIP_MIX & 4) ? *(const u32x4*)(WSP(bf16_t, WS_UV) + (i >> 7) * UV_W + (i & 127) * 8) : (u32x4){0u, 0u, 0u, 0u}; }
            else sgu_phase(lds, WSP(bf16_t, WS_UV), rsqv, a.in[4], a.in[5], a.in[6], WSP(bf16_t, WS_SGU), vcu, G, tid, lane, wave);
        } else if (k == 3 && (EXP_SKIP_MIX & 8)) {
            for (size_t i = (size_t)gw * 64 + lane; i < (size_t)MC * DM / 8; i += (size_t)ngw * 64) WSP(u32x4, WS_MERGED)[i] = *(const u32x4*)(WSP(bf16_t, WS_GG) + (i >> 7) * GG_W + ((i >> 7) & 1) * 1024 + (i & 127) * 8);
        } else if (k == 3) {
            pg8::StaticOrder So; So.init(MC, DM, G, bx);
            pg8::EpiMid Mh{WSP(bf16_t, WS_GG)}; pg8::EpiMerge E{WSP(bf16_t, WS_GG), WSP(bf16_t, WS_MERGED)};
            pg8::gemm_phase_dual<pg8::EpiMid, pg8::EpiMerge, pg8::StaticOrder>(lds, WSP(bf16_t, WS_ATTN), WSP(bf16_t, WS_WA), AO / 64, WSP(bf16_t, WS_SGU), WSP(bf16_t, WS_WB), DM / 64, DM, So, Mh, E);
        } else if (k == 4) {
            pg8::Gemm g{WSP(bf16_t, WS_MERGED), WSP(bf16_t, WS_WO), MC, DM, DM}; pg8::StaticOrder So; So.init(MC, DM, G, bx);
            pg8::EpiRes<true> E{xin, xout, WSP(bf16_t, WS_X1B), rsq1};
            pg8::gemm_phase<pg8::EpiRes<true>, pg8::StaticOrder, true, true>(lds, g, So, E);
        } else if (k == 5) {
            pg8::Gemm g{WSP(bf16_t, WS_X1B), WSP(bf16_t, WS_WUP), MC, FF, DM}; pg8::StaticOrder So; So.init(MC, FF, G, bx);
            pg8::EpiUp E{rsq1, WSP(bf16_t, WS_UP)};
            pg8::gemm_phase<pg8::EpiUp, pg8::StaticOrder, true, true>(lds, g, So, E);
        } else {
            pg8::Gemm g{WSP(bf16_t, WS_UP), WSP(bf16_t, WS_WDN), MC, DM, FF}; pg8::StaticOrder So; So.init(MC, DM, G, bx);
            pg8::EpiFinal E{WSP(bf16_t, WS_X1B), xout, rsq2, WSP(unsigned, OFF_PCNT) + (size_t)c * 128 * 64, a.in[13]};
            pg8::gemm_phase<pg8::EpiFinal, pg8::StaticOrder, true, true>(lds, g, So, E);
        }
    }
}

extern "C" void kernel_launch(void* const* d_in, const int* in_sizes, int n_in, void* d_out, int out_size, void* d_ws, size_t ws_size, hipStream_t stream) {
    static int grid = 0;
    if (grid == 0) {
        if (n_in != 14 || out_size != M_ALL * DM || ws_size < WS_END) { fprintf(stderr, "kernel_launch: unexpected shapes (n_in %d out %d ws %zu); nothing launched\n", n_in, out_size, ws_size); grid = -1; return; }
        int dev = 0, cus = 0, per_cu = 0;
        if (hipGetDevice(&dev) != hipSuccess || hipDeviceGetAttribute(&cus, hipDeviceAttributeMultiprocessorCount, dev) != hipSuccess) { grid = -1; return; }
        if (hipFuncSetAttribute((const void*)mega_fwd, hipFuncAttributeMaxDynamicSharedMemorySize, LDS_BYTES) != hipSuccess) { fprintf(stderr, "kernel_launch: hipFuncSetAttribute failed\n"); grid = -1; return; }
        if (hipOccupancyMaxActiveBlocksPerMultiprocessor(&per_cu, (const void*)mega_fwd, 512, LDS_BYTES) != hipSuccess || per_cu < 1) { fprintf(stderr, "kernel_launch: occupancy query gave %d\n", per_cu); per_cu = 1; }
        (void)hipGetLastError();
        grid = cus * per_cu;
    }
    if (grid < 0) return;
    (void)hipMemsetAsync((char*)d_ws + WS_BAR, 0, BAR_BYTES, stream);
    Args a{};
    for (int i = 0; i < 14; ++i) a.in[i] = (const float*)d_in[i];
    a.out = (float*)d_out; a.ws = (unsigned char*)d_ws;
#if MK_MULTI
    for (int p = 0; p < N_PHASES; ++p) { a.ph_lo = p; a.ph_hi = p + 1; hipLaunchKernelGGL(mega_fwd, dim3(grid), dim3(512), LDS_BYTES, stream, a); }
#else
    a.ph_lo = 0; a.ph_hi = N_PHASES;
    void* args[] = {&a};
    hipError_t e = hipLaunchCooperativeKernel((const void*)mega_fwd, dim3(grid), dim3(512), args, LDS_BYTES, stream);
    if (e != hipSuccess) fprintf(stderr, "cooperative launch failed: %s (grid %d)\n", hipGetErrorString(e), grid);
#endif
}
```

```cpp
#include <hip/hip_runtime.h>
#include <hip/hip_cooperative_groups.h>
#include <cstdio>
#include <cstdint>
namespace cg = cooperative_groups;

#define LAS __attribute__((address_space(3)))
typedef unsigned short bf16_t;
typedef short bf16x8 __attribute__((ext_vector_type(8)));
typedef short s16x4 __attribute__((ext_vector_type(4)));
typedef float f32x4 __attribute__((ext_vector_type(4)));
typedef float f32x2 __attribute__((ext_vector_type(2)));
typedef unsigned u32x4 __attribute__((ext_vector_type(4)));
typedef unsigned u32x2 __attribute__((ext_vector_type(2)));

constexpr int DM = 1024, MC = 32768, NCHUNK = 3, M_ALL = MC * NCHUNK;
constexpr int IN_COLS = 8704, QKV_W = 4608, UV_W = 2048, GG_W = 2048, FF = 4096, AO = 512;
constexpr float EPS = 1e-6f;
constexpr float LOG2E = 1.4426950408889634f;

constexpr size_t MiB = 1u << 20;
constexpr size_t WS_CTL = 0, CTL_BYTES = 1536 * 1024;
constexpr size_t WS_BAR = 1536 * 1024, BAR_BYTES = 16384;
constexpr int LDS_MISC_OFF = 131072 + 512;
constexpr size_t OFF_RSQV = 0, OFF_RSQ1 = 512 * 1024, OFF_RSQ2 = 1024 * 1024, OFF_PCNT = 1408 * 1024;
constexpr size_t WS_WIN = 4 * MiB, WS_WA = 22 * MiB, WS_WB = 24 * MiB, WS_WO = 26 * MiB, WS_WUP = 28 * MiB, WS_WDN = 36 * MiB;
constexpr size_t WS_H = 48 * MiB;
constexpr size_t WS_QKV = 112 * MiB;
constexpr size_t WS_UV = 400 * MiB;
constexpr size_t WS_GG = 528 * MiB;
constexpr size_t WS_PO = 656 * MiB;
constexpr size_t WS_PS = 720 * MiB;
constexpr size_t WS_ATTN = 724 * MiB;
constexpr size_t WS_SGU = 788 * MiB;
constexpr size_t WS_END = 852 * MiB;
constexpr size_t WS_T1 = WS_QKV;
constexpr size_t WS_MERGED = WS_QKV + 128 * MiB;
constexpr size_t WS_X1B = WS_QKV + 192 * MiB;
constexpr size_t WS_UP = WS_UV;

constexpr int LDS_BYTES = 147456;
#ifndef MK_MULTI
#define MK_MULTI 0
#endif
#ifndef EXP_SS
#define EXP_SS true
#endif
#ifndef EXP_GMODE
#define EXP_GMODE 2
#endif
#ifndef EXP_SKIP_MIX
#define EXP_SKIP_MIX 0
#endif

namespace pg8 {
constexpr int BM = 256, BK = 64, HALF = 128, HTB = HALF * BK * 2, STAGE_BYTES = 8 * HTB, NXCD = 8, WGM = 8;
__host__ __device__ __forceinline__ int lds_byte(int r, int c) { const int st = (r >> 4) * 2 + (c >> 5), rr = r & 15, cc = c & 31, ob = rr * 64 + cc * 2; return st * 1024 + (ob ^ (((ob >> 9) & 1) << 5)); }
__host__ __device__ __forceinline__ void stage_rc(int b, int& R, int& C) { const int st = b / 1024, sb = b % 1024, swz = sb ^ (((sb >> 9) & 1) << 5); R = (st >> 1) * 16 + swz / 64; C = (st & 1) * 32 + (swz % 64) / 2; }
__host__ __device__ __forceinline__ int perm32(int rho) { const int n = rho >> 4, i = rho & 15; return 8 * (i >> 2) + 4 * n + (i & 3); }

struct Unit { int pm, pn; };
struct Gemm { const bf16_t* A; const bf16_t* Bt; int M, N, K; };

struct StaticOrder {
    int nM, nN, nwg, G, c;
    __host__ __device__ void init(int M, int N, int G_, int c_) { nM = M / BM; nN = N / BM; nwg = nM * nN; G = G_; c = c_; }
    __host__ __device__ bool next(int i, Unit& u) const {
        const long L = (long)i * G + c; if (L >= nwg) return false;
        int wgid = (int)L; { const int q = nwg / NXCD, r = nwg % NXCD, xcd = wgid % NXCD, off = wgid / NXCD; wgid = (xcd < r ? xcd * (q + 1) : r * (q + 1) + (xcd - r) * q) + off; }
        const int nig = WGM * nN, gid = wgid / nig, fm = gid * WGM, gsz = (nM - fm) < WGM ? (nM - fm) : WGM;
        u.pm = fm + ((wgid % nig) % gsz); u.pn = (wgid % nig) / gsz; return true;
    }
    __device__ __forceinline__ void a_ready(const Unit&) const {}
    __device__ __forceinline__ void done(const Unit&) const {}
};

typedef __bf16 bf16x2_t __attribute__((ext_vector_type(2)));
__device__ __forceinline__ unsigned cvt_pk_bf16(float lo, float hi) { const bf16x2_t r = __builtin_convertvector((f32x2){lo, hi}, bf16x2_t); return __builtin_bit_cast(unsigned, r); }
__device__ __forceinline__ f32x2 gelu_pk(f32x2 v) {
    const f32x2 av = __builtin_elementwise_abs(v), d = av * 0.2316418882f + 1.0f;
    f32x2 t; t.x = __builtin_amdgcn_rcpf(d.x); t.y = __builtin_amdgcn_rcpf(d.y);
    f32x2 q = t * 0.5307027145f + (-0.7265760135f); q = q * t + 0.7107068705f; q = q * t + (-0.142248368f); q = q * t + 0.127414796f; q = q * t;
    const f32x2 s = (v * v) * (-0.72134752044f);
    f32x2 e; e.x = __builtin_amdgcn_exp2f(s.x); e.y = __builtin_amdgcn_exp2f(s.y);
    const f32x2 m = v * (q * e), r = v - m;
    f32x2 o; o.x = v.x < 0.f ? m.x : r.x; o.y = v.y < 0.f ? m.y : r.y; return o;
}
__device__ __forceinline__ f32x4 gelu4(f32x4 v) { f32x2 a = gelu_pk((f32x2){v[0], v[1]}), b = gelu_pk((f32x2){v[2], v[3]}); return (f32x4){a.x, a.y, b.x, b.y}; }
__device__ __forceinline__ float sigm(float x) { return __builtin_amdgcn_rcpf(1.0f + __builtin_amdgcn_exp2f(-x * LOG2E)); }
__device__ __forceinline__ f32x4 sigm4(f32x4 v) { return (f32x4){sigm(v[0]), sigm(v[1]), sigm(v[2]), sigm(v[3])}; }
__device__ __forceinline__ u32x4 pack8(f32x4 v0, f32x4 v1) { u32x4 w; w.x = cvt_pk_bf16(v0[0], v0[1]); w.y = cvt_pk_bf16(v0[2], v0[3]); w.z = cvt_pk_bf16(v1[0], v1[1]); w.w = cvt_pk_bf16(v1[2], v1[3]); return w; }
__device__ __forceinline__ float bf_lo(unsigned w) { return __uint_as_float(w << 16); }
__device__ __forceinline__ float bf_hi(unsigned w) { return __uint_as_float(w & 0xffff0000u); }
__device__ __forceinline__ float dot4(f32x4 v) { return (v[0] * v[0] + v[1] * v[1]) + (v[2] * v[2] + v[3] * v[3]); }

struct EpiProj {
    static constexpr bool PERM = true, AFTER_DRAIN = false;
    bf16_t* qkv; bf16_t* uv; bf16_t* gg; float* rowsq;
    template <int MODE, bool SS>
    __device__ __forceinline__ void tile(const f32x4 (&acc)[2][2][4][2], bf16_t* base, int ld, int row0, int col0) const {
#pragma unroll
        for (int ai = 0; ai < 2; ++ai)
#pragma unroll
            for (int m = 0; m < 4; ++m) { const int row = row0 + ai * HALF + m * 16; bf16_t* rowp = base + (size_t)row * ld + col0; float ss = 0.f;
#pragma unroll
                for (int bj = 0; bj < 2; ++bj) { f32x4 v0 = acc[ai][bj][m][0], v1 = acc[ai][bj][m][1];
                    if (MODE == 1) { v0 = gelu4(v0); v1 = gelu4(v1); }
                    if (MODE == 2) { v0 = sigm4(v0); v1 = sigm4(v1); }
                    if (SS) ss += dot4(v0) + dot4(v1);
                    *(u32x4*)(rowp + bj * HALF) = pack8(v0, v1); }
                if (SS) { ss += __shfl_xor(ss, 16); ss += __shfl_xor(ss, 32); if ((threadIdx.x & 48) == 0) unsafeAtomicAdd(rowsq + row, ss); }
                asm volatile("" ::: "memory"); }
    }
    __device__ __forceinline__ void operator()(const f32x4 (&acc)[2][2][4][2], const Unit& u, int wr, int wc, int fr, int fq) const {
        const int pn = u.pn, row0 = u.pm * BM + wr * 64 + fr, cw = wc * 32 + 8 * fq;
        if (pn < 18) {
#pragma unroll
            for (int ai = 0; ai < 2; ++ai)
#pragma unroll
                for (int m = 0; m < 4; ++m) { const int row = row0 + ai * HALF + m * 16;
#pragma unroll
                    for (int bj = 0; bj < 2; ++bj) { const int hh = pn * 4 + bj * 2 + (wc >> 1);
                        *(u32x4*)(qkv + ((size_t)hh * MC + row) * 64 + (wc & 1) * 32 + 8 * fq) = pack8(acc[ai][bj][m][0], acc[ai][bj][m][1]); }
                    asm volatile("" ::: "memory"); }
        }
        else if (pn < 22) tile<1, false>(acc, uv, UV_W, row0, (pn - 18) * 256 + cw);
        else if (pn < 26) tile<1, EXP_SS>(acc, uv, UV_W, row0, (pn - 18) * 256 + cw);
        else tile<EXP_GMODE, false>(acc, gg, GG_W, row0, (pn - 26) * 256 + cw);
    }
};
struct EpiM1 {
    static constexpr bool PERM = true, AFTER_DRAIN = false;
    const bf16_t* gate; bf16_t* t1;
    __device__ __forceinline__ void operator()(const f32x4 (&acc)[2][2][4][2], const Unit& u, int wr, int wc, int fr, int fq) const {
        const int row0 = u.pm * BM + wr * 64 + fr, col0 = u.pn * BM + wc * 32 + 8 * fq;
#pragma unroll
        for (int ai = 0; ai < 2; ++ai)
#pragma unroll
            for (int m = 0; m < 4; ++m) { const size_t row = row0 + ai * HALF + m * 16;
#pragma unroll
                for (int bj = 0; bj < 2; ++bj) { const u32x4 gw = *(const u32x4*)(gate + row * GG_W + col0 + bj * HALF);
                    f32x4 v0 = acc[ai][bj][m][0], v1 = acc[ai][bj][m][1];
                    v0 = v0 * (f32x4){bf_lo(gw.x), bf_hi(gw.x), bf_lo(gw.y), bf_hi(gw.y)}; v1 = v1 * (f32x4){bf_lo(gw.z), bf_hi(gw.z), bf_lo(gw.w), bf_hi(gw.w)};
                    *(u32x4*)(t1 + row * DM + col0 + bj * HALF) = pack8(v0, v1); }
                if (m & 1) asm volatile("" ::: "memory"); }
    }
};
struct EpiM2 {
    static constexpr bool PERM = true, AFTER_DRAIN = false;
    const bf16_t* gate; const bf16_t* t1; bf16_t* merged;
    __device__ __forceinline__ void operator()(const f32x4 (&acc)[2][2][4][2], const Unit& u, int wr, int wc, int fr, int fq) const {
        const int row0 = u.pm * BM + wr * 64 + fr, col0 = u.pn * BM + wc * 32 + 8 * fq;
#pragma unroll
        for (int ai = 0; ai < 2; ++ai)
#pragma unroll
            for (int m = 0; m < 4; ++m) { const size_t row = row0 + ai * HALF + m * 16;
#pragma unroll
                for (int bj = 0; bj < 2; ++bj) { const u32x4 gw = *(const u32x4*)(gate + row * GG_W + col0 + bj * HALF);
                    const u32x4 tw = *(const u32x4*)(t1 + row * DM + col0 + bj * HALF); const f32x4 a0 = (f32x4){bf_lo(tw.x), bf_hi(tw.x), bf_lo(tw.y), bf_hi(tw.y)}, a1 = (f32x4){bf_lo(tw.z), bf_hi(tw.z), bf_lo(tw.w), bf_hi(tw.w)};
                    f32x4 v0 = acc[ai][bj][m][0], v1 = acc[ai][bj][m][1];
                    v0 = a0 + v0 * (f32x4){bf_lo(gw.x), bf_hi(gw.x), bf_lo(gw.y), bf_hi(gw.y)}; v1 = a1 + v1 * (f32x4){bf_lo(gw.z), bf_hi(gw.z), bf_lo(gw.w), bf_hi(gw.w)};
                    *(u32x4*)(merged + row * DM + col0 + bj * HALF) = pack8(v0, v1); }
                if (m & 1) asm volatile("" ::: "memory"); }
    }
};
struct EpiMid {
    const bf16_t* gg;
    __device__ __forceinline__ void operator()(f32x4 (&acc)[2][2][4][2], const Unit& u, int wr, int wc, int fr, int fq) const {
        const int row0 = u.pm * BM + wr * 64 + fr, col0 = u.pn * BM + wc * 32 + 8 * fq;
#pragma unroll
        for (int ai = 0; ai < 2; ++ai)
#pragma unroll
            for (int m = 0; m < 4; ++m) { const size_t row = row0 + ai * HALF + m * 16;
#pragma unroll
                for (int bj = 0; bj < 2; ++bj) { const u32x4 aw = *(const u32x4*)(gg + row * GG_W + col0 + bj * HALF), bw = *(const u32x4*)(gg + row * GG_W + 1024 + col0 + bj * HALF);
                    const f32x4 sa0 = (f32x4){bf_lo(aw.x), bf_hi(aw.x), bf_lo(aw.y), bf_hi(aw.y)}, sa1 = (f32x4){bf_lo(aw.z), bf_hi(aw.z), bf_lo(aw.w), bf_hi(aw.w)};
                    f32x4 sb0 = (f32x4){bf_lo(bw.x), bf_hi(bw.x), bf_lo(bw.y), bf_hi(bw.y)}, sb1 = (f32x4){bf_lo(bw.z), bf_hi(bw.z), bf_lo(bw.w), bf_hi(bw.w)};
                    const f32x4 tiny = (f32x4){1e-30f, 1e-30f, 1e-30f, 1e-30f};
                    sb0 = __builtin_elementwise_max(sb0, tiny); sb1 = __builtin_elementwise_max(sb1, tiny);
                    const f32x4 r0 = sa0 * (f32x4){__builtin_amdgcn_rcpf(sb0[0]), __builtin_amdgcn_rcpf(sb0[1]), __builtin_amdgcn_rcpf(sb0[2]), __builtin_amdgcn_rcpf(sb0[3])};
                    const f32x4 r1 = sa1 * (f32x4){__builtin_amdgcn_rcpf(sb1[0]), __builtin_amdgcn_rcpf(sb1[1]), __builtin_amdgcn_rcpf(sb1[2]), __builtin_amdgcn_rcpf(sb1[3])};
                    acc[ai][bj][m][0] *= r0; acc[ai][bj][m][1] *= r1; }
                if (m & 1) asm volatile("" ::: "memory"); }
    }
};
struct EpiMerge {
    const bf16_t* gg; bf16_t* merged;
    __device__ __forceinline__ void operator()(f32x4 (&acc)[2][2][4][2], const Unit& u, int wr, int wc, int fr, int fq) const {
        const int row0 = u.pm * BM + wr * 64 + fr, col0 = u.pn * BM + wc * 32 + 8 * fq;
#pragma unroll
        for (int ai = 0; ai < 2; ++ai)
#pragma unroll
            for (int m = 0; m < 4; ++m) { const size_t row = row0 + ai * HALF + m * 16;
#pragma unroll
                for (int bj = 0; bj < 2; ++bj) { const u32x4 bw = *(const u32x4*)(gg + row * GG_W + 1024 + col0 + bj * HALF);
                    const f32x4 v0 = acc[ai][bj][m][0] * (f32x4){bf_lo(bw.x), bf_hi(bw.x), bf_lo(bw.y), bf_hi(bw.y)}, v1 = acc[ai][bj][m][1] * (f32x4){bf_lo(bw.z), bf_hi(bw.z), bf_lo(bw.w), bf_hi(bw.w)};
                    *(u32x4*)(merged + row * DM + col0 + bj * HALF) = pack8(v0, v1); }
                if (m & 1) asm volatile("" ::: "memory"); }
    }
};
template <bool WB16> struct EpiRes {
    static constexpr bool PERM = true, AFTER_DRAIN = false;
    const float* xi; float* xo; bf16_t* xb; float* rowsq;
    __device__ __forceinline__ void operator()(const f32x4 (&acc)[2][2][4][2], const Unit& u, int wr, int wc, int fr, int fq) const {
        const int row0 = u.pm * BM + wr * 64 + fr, col0 = u.pn * BM + wc * 32 + 8 * fq;
#pragma unroll
        for (int ai = 0; ai < 2; ++ai)
#pragma unroll
            for (int m = 0; m < 4; ++m) { const size_t row = row0 + ai * HALF + m * 16; float ss = 0.f;
#pragma unroll
                for (int bj = 0; bj < 2; ++bj) { const size_t off = row * DM + col0 + bj * HALF;
                    const f32x4 a0 = *(const f32x4*)(xi + off), a1 = *(const f32x4*)(xi + off + 4);
                    const f32x4 v0 = a0 + acc[ai][bj][m][0], v1 = a1 + acc[ai][bj][m][1];
                    ss += dot4(v0) + dot4(v1);
                    if (!WB16) { *(f32x4*)(xo + off) = v0; *(f32x4*)(xo + off + 4) = v1; }
                    if (WB16) *(u32x4*)(xb + off) = pack8(v0, v1); }
                ss += __shfl_xor(ss, 16); ss += __shfl_xor(ss, 32); if ((threadIdx.x & 48) == 0) unsafeAtomicAdd(rowsq + row, ss);
                if (m & 1) asm volatile("" ::: "memory"); }
    }
};
struct EpiFinal {
    static constexpr bool PERM = true, AFTER_DRAIN = false;
    const bf16_t* xi; float* xo; float* rowsq; unsigned* cnt; const float* gfin;
    __device__ __forceinline__ void operator()(f32x4 (&acc)[2][2][4][2], const Unit& u, int wr, int wc, int fr, int fq) const {
        const int row0 = u.pm * BM + wr * 64 + fr, col0 = u.pn * BM + wc * 32 + 8 * fq;
#pragma unroll
        for (int ai = 0; ai < 2; ++ai)
#pragma unroll
            for (int m = 0; m < 4; ++m) { const size_t row = row0 + ai * HALF + m * 16; float ss = 0.f;
#pragma unroll
                for (int bj = 0; bj < 2; ++bj) { const size_t off = row * DM + col0 + bj * HALF;
                    const u32x4 xw = *(const u32x4*)(xi + off);
                    acc[ai][bj][m][0] += (f32x4){bf_lo(xw.x), bf_hi(xw.x), bf_lo(xw.y), bf_hi(xw.y)}; acc[ai][bj][m][1] += (f32x4){bf_lo(xw.z), bf_hi(xw.z), bf_lo(xw.w), bf_hi(xw.w)};
                    ss += dot4(acc[ai][bj][m][0]) + dot4(acc[ai][bj][m][1]); }
                ss += __shfl_xor(ss, 16); ss += __shfl_xor(ss, 32); if ((threadIdx.x & 48) == 0) unsafeAtomicAdd(rowsq + row, ss);
                if (m & 1) asm volatile("" ::: "memory"); }
        asm volatile("s_waitcnt vmcnt(0)" ::: "memory");
        unsigned* pc = cnt + 64 * u.pm;
        if ((threadIdx.x & 63) == 0) __hip_atomic_fetch_add(pc, 1u, __ATOMIC_RELAXED, __HIP_MEMORY_SCOPE_AGENT);
        { unsigned sp = 0;
          while ((unsigned)__builtin_amdgcn_readfirstlane(__hip_atomic_load(pc, __ATOMIC_RELAXED, __HIP_MEMORY_SCOPE_AGENT)) < 32u) { __builtin_amdgcn_s_sleep(1); if (++sp > (1u << 22)) break; } }
        f32x4 gv[2][2];
#pragma unroll
        for (int bj = 0; bj < 2; ++bj) { gv[bj][0] = *(const f32x4*)(gfin + col0 + bj * HALF); gv[bj][1] = *(const f32x4*)(gfin + col0 + bj * HALF + 4); }
#pragma unroll
        for (int ai = 0; ai < 2; ++ai)
#pragma unroll
            for (int m = 0; m < 4; ++m) { const size_t row = row0 + ai * HALF + m * 16;
                const float q = __hip_atomic_load(rowsq + row, __ATOMIC_RELAXED, __HIP_MEMORY_SCOPE_AGENT);
                const float rs = __builtin_amdgcn_rsqf(q * (1.0f / DM) + EPS);
#pragma unroll
                for (int bj = 0; bj < 2; ++bj) { const size_t off = row * DM + col0 + bj * HALF;
                    *(f32x4*)(xo + off) = acc[ai][bj][m][0] * rs * gv[bj][0]; *(f32x4*)(xo + off + 4) = acc[ai][bj][m][1] * rs * gv[bj][1]; }
                if (m & 1) asm volatile("" ::: "memory"); }
    }
};
struct EpiUp {
    static constexpr bool PERM = true, AFTER_DRAIN = false;
    const float* rowsq; bf16_t* up;
    __device__ __forceinline__ void operator()(const f32x4 (&acc)[2][2][4][2], const Unit& u, int wr, int wc, int fr, int fq) const {
        const int row0 = u.pm * BM + wr * 64 + fr, col0 = u.pn * BM + wc * 32 + 8 * fq;
        float rsv[2][4];
#pragma unroll
        for (int ai = 0; ai < 2; ++ai)
#pragma unroll
            for (int m = 0; m < 4; ++m) rsv[ai][m] = rowsq[row0 + ai * HALF + m * 16];
#pragma unroll
        for (int ai = 0; ai < 2; ++ai)
#pragma unroll
            for (int m = 0; m < 4; ++m) { const size_t row = row0 + ai * HALF + m * 16; const float rs = __builtin_amdgcn_rsqf(rsv[ai][m] * (1.0f / DM) + EPS);
#pragma unroll
                for (int bj = 0; bj < 2; ++bj) { f32x4 v0 = acc[ai][bj][m][0] * rs, v1 = acc[ai][bj][m][1] * rs;
                    v0 = __builtin_elementwise_max(v0, (f32x4){0.f, 0.f, 0.f, 0.f}); v1 = __builtin_elementwise_max(v1, (f32x4){0.f, 0.f, 0.f, 0.f});
                    v0 = v0 * v0; v1 = v1 * v1;
                    *(u32x4*)(up + row * FF + col0 + bj * HALF) = pack8(v0, v1); }
                asm volatile("" ::: "memory"); }
    }
};

template <class Epi, class Sched, bool ALIGN_EPI = false, bool SP2 = false>
__device__ __forceinline__ void gemm_phase(LAS unsigned char* lds, const Gemm g, const Sched& S, const Epi& E) {
    int tid_ = threadIdx.x; asm volatile("" : "+v"(tid_));
    const int tid = tid_, wid = __builtin_amdgcn_readfirstlane(tid >> 6), lane = tid & 63, wr = wid >> 2, wc = wid & 3, fr = lane & 15, fq = lane >> 4;
    const int K = g.K, nt = K / BK;
    unsigned voffA[2], voffB[2];
#pragma unroll
    for (int i = 0; i < 2; ++i) { int R, C; stage_rc(tid * 16 + i * 8192, R, C); const int Rb = Epi::PERM ? ((R & ~31) + perm32(R & 31)) : R;
        voffA[i] = (unsigned)(R * K + C) * 2u; voffB[i] = (unsigned)(Rb * K + C) * 2u; }
    const size_t kstep = (size_t)(BK * 2);
    const size_t hstep = (size_t)HALF * K * 2;
    const size_t tstep = 2 * hstep;
    const unsigned ldsw = (unsigned)wid * 1024u;
    const int aoff = lds_byte(wr * 64 + fr, fq * 8), boff = lds_byte(wc * 32 + fr, fq * 8);
#define PG8_SA(b, h) (((b) * 2 + (h)) * HTB)
#define PG8_SB(b, h) ((4 + (b) * 2 + (h)) * HTB)
#define PG8_STAGE(bufoff, gbase, voff) do { _Pragma("unroll") for (int _i = 0; _i < 2; ++_i) \
        __builtin_amdgcn_global_load_lds((const unsigned*)((const char*)(gbase) + (voff)[_i]), (LAS unsigned*)(lds + (bufoff) + ldsw + _i * 8192), 16, 0, 0); } while (0)
#define PG8_LDA(dst, b, h) do { _Pragma("unroll") for (int m = 0; m < 4; ++m) _Pragma("unroll") for (int k = 0; k < 2; ++k) dst[m][k] = *(const LAS bf16x8*)(lds + PG8_SA(b, h) + aoff + m * 2048 + k * 1024); } while (0)
#define PG8_LDB(dst, b, h) do { _Pragma("unroll") for (int n = 0; n < 2; ++n) _Pragma("unroll") for (int k = 0; k < 2; ++k) dst[n][k] = *(const LAS bf16x8*)(lds + PG8_SB(b, h) + boff + n * 2048 + k * 1024); } while (0)
#define PG8_MMA(ai, bj, At, Bt) do { __builtin_amdgcn_s_setprio(1); _Pragma("unroll") for (int m = 0; m < 4; ++m) _Pragma("unroll") for (int n = 0; n < 2; ++n) _Pragma("unroll") for (int k = 0; k < 2; ++k) \
        acc[ai][bj][m][n] = __builtin_amdgcn_mfma_f32_16x16x32_bf16(Bt[n][k], At[m][k], acc[ai][bj][m][n], 0, 0, 0); __builtin_amdgcn_s_setprio(0); } while (0)
#define PG8_WAIT_V(n) asm volatile("s_waitcnt vmcnt(" #n ")" ::: "memory")
#define PG8_WAIT_L(n) asm volatile("s_waitcnt lgkmcnt(" #n ")" ::: "memory")
#define PG8_BAR __builtin_amdgcn_s_barrier()
#define PG8_SCHED __builtin_amdgcn_sched_barrier(0)
    Unit cur, nxt; int ui = 0;
    if (!S.next(0, cur)) return;
    f32x4 acc[2][2][4][2];
#pragma unroll
    for (int a = 0; a < 2; ++a)
#pragma unroll
        for (int b = 0; b < 2; ++b)
#pragma unroll
            for (int m = 0; m < 4; ++m)
#pragma unroll
                for (int n = 0; n < 2; ++n) acc[a][b][m][n] = (f32x4){0.f, 0.f, 0.f, 0.f};
    bf16x8 At[4][2], B0[2][2], B1[2][2];
    const char* cA = (const char*)g.A + (size_t)cur.pm * tstep; const char* cB = (const char*)g.Bt + (size_t)cur.pn * tstep;
    S.a_ready(cur);
    if constexpr (SP2) {
        PG8_STAGE(PG8_SB(0, 0), cB, voffB); PG8_STAGE(PG8_SB(0, 1), cB + hstep, voffB); PG8_STAGE(PG8_SA(0, 0), cA, voffA); PG8_STAGE(PG8_SA(0, 1), cA + hstep, voffA);
        if (wr == 1) PG8_BAR;
        PG8_WAIT_V(2); PG8_BAR;
        PG8_STAGE(PG8_SB(1, 0), cB + kstep, voffB); PG8_STAGE(PG8_SA(1, 0), cA + kstep, voffA); PG8_STAGE(PG8_SB(1, 1), cB + hstep + kstep, voffB);
        PG8_WAIT_V(6); PG8_BAR;
    } else {
        PG8_STAGE(PG8_SB(0, 0), cB, voffB); PG8_STAGE(PG8_SA(0, 0), cA, voffA); PG8_STAGE(PG8_SB(0, 1), cB + hstep, voffB); PG8_STAGE(PG8_SA(0, 1), cA + hstep, voffA);
        if (wr == 1) PG8_BAR;
        PG8_WAIT_V(4); PG8_BAR;
        PG8_STAGE(PG8_SB(1, 0), cB + kstep, voffB); PG8_STAGE(PG8_SA(1, 0), cA + kstep, voffA); PG8_STAGE(PG8_SB(1, 1), cB + hstep + kstep, voffB);
        PG8_WAIT_V(6); PG8_BAR;
    }
    for (;;) {
        const bool has_next = S.next(ui + 1, nxt);
        const char* nA = has_next ? (const char*)g.A + (size_t)nxt.pm * tstep : cA; const char* nB = has_next ? (const char*)g.Bt + (size_t)nxt.pn * tstep : cB;
        for (int t = 0; t < nt; t += 2) {
            const bool last = (t == nt - 2);
            const char* a1 = cA + (size_t)(t + 1) * kstep;
            const char* a2 = last ? nA : cA + (size_t)(t + 2) * kstep; const char* b2 = last ? nB : cB + (size_t)(t + 2) * kstep;
            const char* a3 = a2 + kstep; const char* b3 = b2 + kstep;
            if (last && has_next) S.a_ready(nxt);
            if constexpr (SP2) {
            PG8_LDB(B0, 0, 0); PG8_LDB(B1, 0, 1); PG8_SCHED; PG8_LDA(At, 0, 0); PG8_STAGE(PG8_SA(1, 1), a1 + hstep, voffA);
            PG8_WAIT_V(8); PG8_WAIT_L(0); PG8_BAR; PG8_MMA(0, 0, At, B0); PG8_MMA(0, 1, At, B1); PG8_BAR; PG8_SCHED;
            PG8_LDA(At, 0, 1); PG8_STAGE(PG8_SB(0, 0), b2, voffB); PG8_STAGE(PG8_SB(0, 1), b2 + hstep, voffB); PG8_STAGE(PG8_SA(0, 0), a2, voffA);
            PG8_WAIT_V(8); PG8_WAIT_L(0); PG8_BAR; PG8_MMA(1, 0, At, B0); PG8_MMA(1, 1, At, B1); PG8_BAR; PG8_SCHED;
            PG8_LDB(B0, 1, 0); PG8_LDB(B1, 1, 1); PG8_SCHED; PG8_LDA(At, 1, 0); PG8_STAGE(PG8_SA(0, 1), a2 + hstep, voffA);
            PG8_WAIT_V(8); PG8_WAIT_L(0); PG8_BAR; PG8_MMA(0, 0, At, B0); PG8_MMA(0, 1, At, B1); PG8_BAR; PG8_SCHED;
            PG8_LDA(At, 1, 1); PG8_STAGE(PG8_SB(1, 0), b3, voffB); PG8_STAGE(PG8_SB(1, 1), b3 + hstep, voffB); PG8_STAGE(PG8_SA(1, 0), a3, voffA);
            PG8_WAIT_V(8); PG8_WAIT_L(0); PG8_BAR; PG8_MMA(1, 0, At, B0); PG8_MMA(1, 1, At, B1); PG8_BAR; PG8_SCHED;
            } else {
            PG8_LDB(B0, 0, 0); PG8_SCHED; PG8_LDA(At, 0, 0); PG8_STAGE(PG8_SA(1, 1), a1 + hstep, voffA);
            PG8_WAIT_L(8); PG8_BAR; PG8_WAIT_L(0); PG8_MMA(0, 0, At, B0); PG8_BAR; PG8_SCHED;
            PG8_LDB(B1, 0, 1); PG8_STAGE(PG8_SB(0, 0), b2, voffB);
            PG8_BAR; PG8_WAIT_L(0); PG8_MMA(0, 1, At, B1); PG8_BAR;
            PG8_LDA(At, 0, 1); PG8_STAGE(PG8_SA(0, 0), a2, voffA);
            PG8_BAR; PG8_WAIT_L(0); PG8_MMA(1, 0, At, B0); PG8_BAR; PG8_SCHED;
            PG8_STAGE(PG8_SB(0, 1), b2 + hstep, voffB);
            PG8_WAIT_V(6); PG8_BAR; PG8_MMA(1, 1, At, B1); PG8_BAR;
            PG8_LDB(B0, 1, 0); PG8_SCHED; PG8_LDA(At, 1, 0); PG8_STAGE(PG8_SA(0, 1), a2 + hstep, voffA);
            PG8_WAIT_L(8); PG8_BAR; PG8_WAIT_L(0); PG8_MMA(0, 0, At, B0); PG8_BAR; PG8_SCHED;
            PG8_LDB(B1, 1, 1); PG8_STAGE(PG8_SB(1, 0), b3, voffB);
            PG8_BAR; PG8_WAIT_L(0); PG8_MMA(0, 1, At, B1); PG8_BAR;
            PG8_LDA(At, 1, 1); PG8_STAGE(PG8_SA(1, 0), a3, voffA);
            PG8_BAR; PG8_WAIT_L(0); PG8_MMA(1, 0, At, B0); PG8_BAR; PG8_SCHED;
            PG8_STAGE(PG8_SB(1, 1), b3 + hstep, voffB);
            PG8_WAIT_V(6); PG8_BAR; PG8_MMA(1, 1, At, B1); PG8_BAR;
            }
        }
        if constexpr (ALIGN_EPI) { if (wr == 0) PG8_BAR; }
        if constexpr (!Epi::AFTER_DRAIN) { E(acc, cur, wr, wc, fr, fq); S.done(cur); }
        if (!has_next) break;
#pragma unroll
        for (int a = 0; a < 2; ++a)
#pragma unroll
            for (int b = 0; b < 2; ++b)
#pragma unroll
                for (int m = 0; m < 4; ++m)
#pragma unroll
                    for (int n = 0; n < 2; ++n) acc[a][b][m][n] = (f32x4){0.f, 0.f, 0.f, 0.f};
        cur = nxt; cA = nA; cB = nB; ++ui;
        if constexpr (ALIGN_EPI) { if (wr == 1) PG8_BAR; }
    }
    PG8_WAIT_V(0);
    if constexpr (!ALIGN_EPI) { if (wr == 0) PG8_BAR; }
    PG8_BAR;
#undef PG8_SA
#undef PG8_SB
#undef PG8_STAGE
#undef PG8_LDA
#undef PG8_LDB
#undef PG8_MMA
#undef PG8_WAIT_V
#undef PG8_WAIT_L
#undef PG8_BAR
#undef PG8_SCHED
}

template <class Mid, class Epi, class Sched>
__device__ __forceinline__ void gemm_phase_dual(LAS unsigned char* lds, const bf16_t* A1, const bf16_t* B1, int nt1, const bf16_t* A2, const bf16_t* B2, int nt2, int ld, const Sched& S, const Mid& Mh, const Epi& E) {
    int tid_ = threadIdx.x; asm volatile("" : "+v"(tid_));
    const int tid = tid_, wid = __builtin_amdgcn_readfirstlane(tid >> 6), lane = tid & 63, wr = wid >> 2, wc = wid & 3, fr = lane & 15, fq = lane >> 4;
    unsigned voffA[2], voffB[2];
#pragma unroll
    for (int i = 0; i < 2; ++i) { int R, C; stage_rc(tid * 16 + i * 8192, R, C); const int Rb = ((R & ~31) + perm32(R & 31));
        voffA[i] = (unsigned)(R * ld + C) * 2u; voffB[i] = (unsigned)(Rb * ld + C) * 2u; }
    const size_t kstep = (size_t)(BK * 2);
    const size_t hstep = (size_t)HALF * ld * 2;
    const size_t tstep = 2 * hstep;
    const unsigned ldsw = (unsigned)wid * 1024u;
    const int aoff = lds_byte(wr * 64 + fr, fq * 8), boff = lds_byte(wc * 32 + fr, fq * 8);
#define PG8_SA(b, h) (((b) * 2 + (h)) * HTB)
#define PG8_SB(b, h) ((4 + (b) * 2 + (h)) * HTB)
#define PG8_STAGE(bufoff, gbase, voff) do { _Pragma("unroll") for (int _i = 0; _i < 2; ++_i) \
        __builtin_amdgcn_global_load_lds((const unsigned*)((const char*)(gbase) + (voff)[_i]), (LAS unsigned*)(lds + (bufoff) + ldsw + _i * 8192), 16, 0, 0); } while (0)
#define PG8_LDA(dst, b, h) do { _Pragma("unroll") for (int m = 0; m < 4; ++m) _Pragma("unroll") for (int k = 0; k < 2; ++k) dst[m][k] = *(const LAS bf16x8*)(lds + PG8_SA(b, h) + aoff + m * 2048 + k * 1024); } while (0)
#define PG8_LDB(dst, b, h) do { _Pragma("unroll") for (int n = 0; n < 2; ++n) _Pragma("unroll") for (int k = 0; k < 2; ++k) dst[n][k] = *(const LAS bf16x8*)(lds + PG8_SB(b, h) + boff + n * 2048 + k * 1024); } while (0)
#define PG8_MMA(ai, bj, At, Bt) do { __builtin_amdgcn_s_setprio(1); _Pragma("unroll") for (int m = 0; m < 4; ++m) _Pragma("unroll") for (int n = 0; n < 2; ++n) _Pragma("unroll") for (int k = 0; k < 2; ++k) \
        acc[ai][bj][m][n] = __builtin_amdgcn_mfma_f32_16x16x32_bf16(Bt[n][k], At[m][k], acc[ai][bj][m][n], 0, 0, 0); __builtin_amdgcn_s_setprio(0); } while (0)
#define PG8_WAIT_V(n) asm volatile("s_waitcnt vmcnt(" #n ")" ::: "memory")
#define PG8_WAIT_L(n) asm volatile("s_waitcnt lgkmcnt(" #n ")" ::: "memory")
#define PG8_BAR __builtin_amdgcn_s_barrier()
#define PG8_SCHED __builtin_amdgcn_sched_barrier(0)
    Unit cur, nxt; int ui = 0, seg = 0;
    if (!S.next(0, cur)) return;
    f32x4 acc[2][2][4][2];
#pragma unroll
    for (int a = 0; a < 2; ++a)
#pragma unroll
        for (int b = 0; b < 2; ++b)
#pragma unroll
            for (int m = 0; m < 4; ++m)
#pragma unroll
                for (int n = 0; n < 2; ++n) acc[a][b][m][n] = (f32x4){0.f, 0.f, 0.f, 0.f};
    bf16x8 At[4][2], B0[2][2], B1f[2][2];
    const char* cA = (const char*)A1 + (size_t)cur.pm * tstep; const char* cB = (const char*)B1 + (size_t)cur.pn * tstep; int nt = nt1;
    PG8_STAGE(PG8_SB(0, 0), cB, voffB); PG8_STAGE(PG8_SB(0, 1), cB + hstep, voffB); PG8_STAGE(PG8_SA(0, 0), cA, voffA); PG8_STAGE(PG8_SA(0, 1), cA + hstep, voffA);
    if (wr == 1) PG8_BAR;
    PG8_WAIT_V(2); PG8_BAR;
    PG8_STAGE(PG8_SB(1, 0), cB + kstep, voffB); PG8_STAGE(PG8_SA(1, 0), cA + kstep, voffA); PG8_STAGE(PG8_SB(1, 1), cB + hstep + kstep, voffB);
    PG8_WAIT_V(6); PG8_BAR;
    for (;;) {
        bool has_next; const char* nA; const char* nB; int nnt;
        if (seg == 0) { has_next = true; nA = (const char*)A2 + (size_t)cur.pm * tstep; nB = (const char*)B2 + (size_t)cur.pn * tstep; nnt = nt2; }
        else { has_next = S.next(ui + 1, nxt); nA = has_next ? (const char*)A1 + (size_t)nxt.pm * tstep : cA; nB = has_next ? (const char*)B1 + (size_t)nxt.pn * tstep : cB; nnt = nt1; }
        for (int t = 0; t < nt; t += 2) {
            const bool last = (t == nt - 2);
            const char* a1 = cA + (size_t)(t + 1) * kstep;
            const char* a2 = last ? nA : cA + (size_t)(t + 2) * kstep; const char* b2 = last ? nB : cB + (size_t)(t + 2) * kstep;
            const char* a3 = a2 + kstep; const char* b3 = b2 + kstep;
            PG8_LDB(B0, 0, 0); PG8_LDB(B1f, 0, 1); PG8_SCHED; PG8_LDA(At, 0, 0); PG8_STAGE(PG8_SA(1, 1), a1 + hstep, voffA);
            PG8_WAIT_V(8); PG8_WAIT_L(0); PG8_BAR; PG8_MMA(0, 0, At, B0); PG8_MMA(0, 1, At, B1f); PG8_BAR; PG8_SCHED;
            PG8_LDA(At, 0, 1); PG8_STAGE(PG8_SB(0, 0), b2, voffB); PG8_STAGE(PG8_SB(0, 1), b2 + hstep, voffB); PG8_STAGE(PG8_SA(0, 0), a2, voffA);
            PG8_WAIT_V(8); PG8_WAIT_L(0); PG8_BAR; PG8_MMA(1, 0, At, B0); PG8_MMA(1, 1, At, B1f); PG8_BAR; PG8_SCHED;
            PG8_LDB(B0, 1, 0); PG8_LDB(B1f, 1, 1); PG8_SCHED; PG8_LDA(At, 1, 0); PG8_STAGE(PG8_SA(0, 1), a2 + hstep, voffA);
            PG8_WAIT_V(8); PG8_WAIT_L(0); PG8_BAR; PG8_MMA(0, 0, At, B0); PG8_MMA(0, 1, At, B1f); PG8_BAR; PG8_SCHED;
            PG8_LDA(At, 1, 1); PG8_STAGE(PG8_SB(1, 0), b3, voffB); PG8_STAGE(PG8_SB(1, 1), b3 + hstep, voffB); PG8_STAGE(PG8_SA(1, 0), a3, voffA);
            PG8_WAIT_V(8); PG8_WAIT_L(0); PG8_BAR; PG8_MMA(1, 0, At, B0); PG8_MMA(1, 1, At, B1f); PG8_BAR; PG8_SCHED;
        }
        if (wr == 0) PG8_BAR;
        if (seg == 0) Mh(acc, cur, wr, wc, fr, fq); else E(acc, cur, wr, wc, fr, fq);
        if (seg == 1 && !has_next) break;
        if (seg == 1) {
#pragma unroll
            for (int a = 0; a < 2; ++a)
#pragma unroll
                for (int b = 0; b < 2; ++b)
#pragma unroll
                    for (int m = 0; m < 4; ++m)
#pragma unroll
                        for (int n = 0; n < 2; ++n) acc[a][b][m][n] = (f32x4){0.f, 0.f, 0.f, 0.f};
            cur = nxt; ++ui; }
        cA = nA; cB = nB; nt = nnt; seg ^= 1;
        if (wr == 1) PG8_BAR;
    }
    PG8_WAIT_V(0);
    PG8_BAR;
#undef PG8_SA
#undef PG8_SB
#undef PG8_STAGE
#undef PG8_LDA
#undef PG8_LDB
#undef PG8_MMA
#undef PG8_WAIT_V
#undef PG8_WAIT_L
#undef PG8_BAR
#undef PG8_SCHED
}
}
using pg8::cvt_pk_bf16;

__device__ __forceinline__ float wave_sum(float v) {
#pragma unroll
    for (int o = 1; o < 64; o <<= 1) v += __shfl_xor(v, o);
    return v;
}
__device__ __forceinline__ s16x4 vtr(LAS const unsigned char* p) { return __builtin_bit_cast(s16x4, __builtin_amdgcn_ds_read_tr16_b64_v4i16((LAS s16x4*)p)); }

__device__ __forceinline__ void p0_transpose_item(const float* W, int K, int N, bf16_t* WT, const float* gk, LAS float* scr, int item, int lane, int ldw = 0) {
    if (ldw == 0) ldw = K;
    const int nblk = N / 32, kb = item / nblk, nb = item % nblk, k0 = 64 * kb, n0 = 32 * nb;
#pragma unroll
    for (int i = 0; i < 32; ++i) { const int kk = 2 * i + (lane >> 5); float w = W[(size_t)(k0 + kk) * N + n0 + (lane & 31)]; if (gk) w *= gk[k0 + kk]; scr[kk * 33 + (lane & 31)] = w; }
    asm volatile("s_waitcnt lgkmcnt(0)" ::: "memory");
    const int c = lane & 7;
#pragma unroll
    for (int j = 0; j < 4; ++j) { const int n = (lane >> 3) + 8 * j; const LAS float* s = scr + (8 * c) * 33 + n;
        u32x4 o; o.x = cvt_pk_bf16(s[0 * 33], s[1 * 33]); o.y = cvt_pk_bf16(s[2 * 33], s[3 * 33]); o.z = cvt_pk_bf16(s[4 * 33], s[5 * 33]); o.w = cvt_pk_bf16(s[6 * 33], s[7 * 33]);
        *(u32x4*)(WT + (size_t)(n0 + n) * ldw + k0 + 8 * c) = o; }
    asm volatile("s_waitcnt lgkmcnt(0)" ::: "memory");
}
__device__ __forceinline__ void hprep_rows(const float* x, bf16_t* h, int gw, int ngw, int lane) {
    for (int m = gw; m < MC / 2; m += ngw) {
        const f32x4* xa = (const f32x4*)(x + (size_t)m * DM) + lane; const f32x4* xb = (const f32x4*)(x + (size_t)(m + MC / 2) * DM) + lane;
        f32x4 va[4], vb[4]; float sa = 0.f, sb = 0.f;
#pragma unroll
        for (int j = 0; j < 4; ++j) { va[j] = xa[64 * j]; vb[j] = xb[64 * j]; }
#pragma unroll
        for (int j = 0; j < 4; ++j) { sa += pg8::dot4(va[j]); sb += pg8::dot4(vb[j]); }
        const float ra = __builtin_amdgcn_rsqf(wave_sum(sa) * (1.0f / DM) + EPS), rb = __builtin_amdgcn_rsqf(wave_sum(sb) * (1.0f / DM) + EPS);
        u32x2* oa = (u32x2*)(h + (size_t)m * DM) + lane; u32x2* ob = (u32x2*)(h + (size_t)(m + MC / 2) * DM) + lane;
#pragma unroll
        for (int j = 0; j < 4; ++j) { u32x2 w; w.x = cvt_pk_bf16(va[j][0] * ra, va[j][1] * ra); w.y = cvt_pk_bf16(va[j][2] * ra, va[j][3] * ra); oa[64 * j] = w;
            u32x2 z; z.x = cvt_pk_bf16(vb[j][0] * rb, vb[j][1] * rb); z.y = cvt_pk_bf16(vb[j][2] * rb, vb[j][3] * rb); ob[64 * j] = z; }
    }
}
__device__ __forceinline__ void final_norm_rows(float* xo, const float* rowsq, const float* gfin, int gw, int ngw, int lane) {
    f32x4 gv[4];
#pragma unroll
    for (int j = 0; j < 4; ++j) gv[j] = ((const f32x4*)gfin)[lane + 64 * j];
    for (int m = gw; m < MC / 2; m += ngw) {
        f32x4* xa = (f32x4*)(xo + (size_t)m * DM) + lane; f32x4* xb = (f32x4*)(xo + (size_t)(m + MC / 2) * DM) + lane;
        const float qa = rowsq[m], qb = rowsq[m + MC / 2];
        f32x4 va[4], vb[4];
#pragma unroll
        for (int j = 0; j < 4; ++j) { va[j] = xa[64 * j]; vb[j] = xb[64 * j]; }
        const float ra = __builtin_amdgcn_rsqf(qa * (1.0f / DM) + EPS), rb = __builtin_amdgcn_rsqf(qb * (1.0f / DM) + EPS);
#pragma unroll
        for (int j = 0; j < 4; ++j) { xa[64 * j] = va[j] * ra * gv[j]; xb[64 * j] = vb[j] * rb * gv[j]; }
    }
}

__device__ __forceinline__ void att_dma16(const void* g, LAS void* l) {
    asm volatile("s_mov_b32 m0, %0\n\ts_nop 0\n\tglobal_load_lds_dwordx4 %1, off" :: "s"((unsigned)(size_t)l), "v"(g) : "memory", "m0");
}
struct AUnit { int g, hj, seq, r, m0, dsh, L; };
__device__ __forceinline__ void attn_decode(int uid, bool combine, int S, AUnit& u) {
    int rem; if (combine) { u.g = 0; rem = uid; } else { u.g = 1 + (uid >> 11); rem = uid & 2047; }
    u.hj = rem & 7; const int blk = rem >> 3;
    u.dsh = 2 * u.g;
    const int lgb = (S == 4096) ? 5 : 6;
    u.seq = blk >> lgb; const int bs = blk & ((1 << lgb) - 1);
    u.L = S >> u.dsh; const int lgr = lgb - u.dsh;
    u.r = bs >> lgr; u.m0 = (bs & ((1 << lgr) - 1)) << 7;
}
template <bool COMBINE>
__device__ __forceinline__ void attn_phase(LAS unsigned char* lds, const bf16_t* qkv, int S, bf16_t* po, float* ps, bf16_t* attn, int vcu, int G, int tid, int lane, int wave) {
    const int nunits = COMBINE ? 2048 : 4096;
    const int fr = lane & 15, fq = lane >> 4;
    bf16x8 qn0, qn1;
    int uid = vcu; if (uid >= nunits) return;
    AUnit cur; attn_decode(uid, COMBINE, S, cur);
#define ATT_STAGE(U, B) do { _Pragma("unroll") for (int i = 0; i < 4; ++i) { const int seg = wave * 4 + i, row = seg * 8 + (lane >> 3), cp = lane & 7; const int mm = (U).m0 - 64 + row; \
        const bool ok = (mm >= 0) && (mm < (U).L); const size_t grow = (size_t)(U).seq * S + ((size_t)(ok ? mm : 0) << (U).dsh) + (U).r; \
        const bf16_t* p = qkv + ((size_t)(24 + (U).g * 8 + (U).hj) * MC + grow) * 64; \
        const int chk = cp ^ (row & 7), chv = cp ^ ((((row >> 1) & 1) << 1) | (((row >> 2) & 1) << 2)); \
        att_dma16(p + chk * 8, lds + (B) * 65536 + seg * 1024); \
        att_dma16(p + (size_t)24 * MC * 64 + chv * 8, lds + (B) * 65536 + 32768 + seg * 1024); } \
        { const int mq_ = (U).m0 + 16 * wave + fr; const size_t rq_ = (size_t)(U).seq * S + ((size_t)mq_ << (U).dsh) + (U).r; \
          const bf16_t* qp_ = qkv + ((size_t)((U).g * 8 + (U).hj) * MC + rq_) * 64 + 8 * fq; qn0 = *(const bf16x8*)qp_; qn1 = *(const bf16x8*)(qp_ + 32); } } while (0)
    int buf = 0;
    ATT_STAGE(cur, 0);
    asm volatile("s_waitcnt vmcnt(0)" ::: "memory");
    for (;;) {
        asm volatile("s_waitcnt vmcnt(4)" ::: "memory");
        __syncthreads();
        LAS unsigned char* kimg = lds + buf * 65536; LAS unsigned char* vimg = kimg + 32768;
        const int mq = cur.m0 + 16 * wave + fr;
        const size_t rowq = (size_t)cur.seq * S + ((size_t)mq << cur.dsh) + cur.r;
        const bf16x8 qf0 = qn0, qf1 = qn1;
        f32x2 s1, s2; u32x2 pa[4], pb[4];
        if constexpr (COMBINE) {
            s1 = *(const f32x2*)(ps + (rowq * 8 + cur.hj) * 2); s2 = *(const f32x2*)(ps + (((size_t)MC + rowq) * 8 + cur.hj) * 2);
            const bf16_t* p1 = po + rowq * AO + cur.hj * 64 + 4 * fq; const bf16_t* p2 = p1 + (size_t)MC * AO;
#pragma unroll
            for (int dt = 0; dt < 4; ++dt) { pa[dt] = *(const u32x2*)(p1 + 16 * dt); pb[dt] = *(const u32x2*)(p2 + 16 * dt); }
        }
        const int nuid = uid + G; const bool hn = nuid < nunits;
        if (hn) { AUnit nxt; attn_decode(nuid, COMBINE, S, nxt); ATT_STAGE(nxt, buf ^ 1); }
        __builtin_amdgcn_sched_barrier(0);
        f32x4 st[9];
        { const int sw = fr & 7; const LAS unsigned char* kb = kimg + (16 * wave + fr) * 128; const int o0 = (fq ^ sw) << 4, o1 = ((4 + fq) ^ sw) << 4;
#pragma unroll
          for (int j = 0; j < 9; ++j) { const bf16x8 k0 = *(const LAS bf16x8*)(kb + j * 2048 + o0), k1 = *(const LAS bf16x8*)(kb + j * 2048 + o1);
              f32x4 z = (f32x4){0.f, 0.f, 0.f, 0.f};
              z = __builtin_amdgcn_mfma_f32_16x16x32_bf16(k0, qf0, z, 0, 0, 0); st[j] = __builtin_amdgcn_mfma_f32_16x16x32_bf16(k1, qf1, z, 0, 0, 0); } }
        const float slope = __builtin_amdgcn_exp2f(-(float)(cur.g * 8 + cur.hj + 1) * (8.0f / 24.0f));
        const float c2 = slope * (float)(1 << cur.dsh) * LOG2E, sc2 = 0.125f * LOG2E;
        float mx = -3.0e38f; float pv[9][4];
        { const int d0 = 4 * fq - fr; const float c2d = c2 * (float)d0; const int klo = cur.m0 + 16 * wave - 64;
#pragma unroll
          for (int j = 0; j < 9; ++j) {
#pragma unroll
              for (int e = 0; e < 4; ++e) { const float t = c2 * (float)(16 * j - 64 + e) + c2d;
                  float s;
                  if (j <= 3) s = st[j][e] * sc2 + t; else if (j >= 5) s = st[j][e] * sc2 - t; else s = st[j][e] * sc2 - __builtin_fabsf(t);
                  if (j == 0) s = (d0 + e < 0) ? -1.0e30f : s;
                  if (j == 8) s = (d0 + e > 0) ? -1.0e30f : s;
                  pv[j][e] = s; }
              const int lo = klo + 16 * j;
              if (lo < 0 || lo + 16 > cur.L) {
#pragma unroll
                  for (int e = 0; e < 4; ++e) { const int mk = lo + 4 * fq + e; pv[j][e] = ((unsigned)mk < (unsigned)cur.L) ? pv[j][e] : -1.0e30f; } }
#pragma unroll
              for (int e = 0; e < 4; ++e) mx = fmaxf(mx, pv[j][e]); } }
        mx = fmaxf(mx, __shfl_xor(mx, 16)); mx = fmaxf(mx, __shfl_xor(mx, 32));
        float lsum = 0.f;
#pragma unroll
        for (int j = 0; j < 9; ++j)
#pragma unroll
            for (int e = 0; e < 4; ++e) { const float p = __builtin_amdgcn_exp2f(pv[j][e] - mx); pv[j][e] = p; lsum += p; }
        lsum += __shfl_xor(lsum, 16); lsum += __shfl_xor(lsum, 32);
        __builtin_amdgcn_sched_barrier(0);
        f32x4 o[4];
#pragma unroll
        for (int dt = 0; dt < 4; ++dt) o[dt] = (f32x4){0.f, 0.f, 0.f, 0.f};
        { const int q = fr >> 2, p = fr & 3; const int fs = ((q >> 1) & 1) | ((fq & 1) << 1);
          const LAS unsigned char* vb = vimg + (16 * wave + 4 * fq + q) * 128 + p * 8;
          int vo[4];
#pragma unroll
          for (int dt = 0; dt < 4; ++dt) vo[dt] = (dt ^ fs) << 5;
#pragma unroll
          for (int kk = 0; kk < 5; ++kk) {
              u32x4 pw; pw.x = cvt_pk_bf16(pv[2 * kk][0], pv[2 * kk][1]); pw.y = cvt_pk_bf16(pv[2 * kk][2], pv[2 * kk][3]);
              if (kk < 4) { pw.z = cvt_pk_bf16(pv[2 * kk + 1 < 9 ? 2 * kk + 1 : 8][0], pv[2 * kk + 1 < 9 ? 2 * kk + 1 : 8][1]); pw.w = cvt_pk_bf16(pv[2 * kk + 1 < 9 ? 2 * kk + 1 : 8][2], pv[2 * kk + 1 < 9 ? 2 * kk + 1 : 8][3]); }
              else { pw.z = 0u; pw.w = 0u; }
              const bf16x8 pf = __builtin_bit_cast(bf16x8, pw);
              const int T0 = 2 * kk, T1 = (2 * kk + 1 < 9) ? 2 * kk + 1 : 8;
#pragma unroll
              for (int dt = 0; dt < 4; ++dt) { const s16x4 a = vtr(vb + T0 * 2048 + vo[dt]), b = vtr(vb + T1 * 2048 + vo[dt]);
                  const bf16x8 vf = __builtin_shufflevector(a, b, 0, 1, 2, 3, 4, 5, 6, 7);
                  o[dt] = __builtin_amdgcn_mfma_f32_16x16x32_bf16(vf, pf, o[dt], 0, 0, 0); } } }
        if constexpr (!COMBINE) {
            const float inv = 1.0f / lsum; const size_t prow = (size_t)(cur.g - 1) * MC + rowq;
            bf16_t* op = po + prow * AO + cur.hj * 64 + 4 * fq;
#pragma unroll
            for (int dt = 0; dt < 4; ++dt) { u32x2 w; w.x = cvt_pk_bf16(o[dt][0] * inv, o[dt][1] * inv); w.y = cvt_pk_bf16(o[dt][2] * inv, o[dt][3] * inv); *(u32x2*)(op + 16 * dt) = w; }
            if (fq == 0) *(f32x2*)(ps + (prow * 8 + cur.hj) * 2) = (f32x2){mx, lsum};
        } else {
            const float Mx = fmaxf(mx, fmaxf(s1.x, s2.x));
            const float e0 = __builtin_amdgcn_exp2f(mx - Mx), w1 = s1.y * __builtin_amdgcn_exp2f(s1.x - Mx), w2 = s2.y * __builtin_amdgcn_exp2f(s2.x - Mx);
            const float invW = 1.0f / (lsum * e0 + w1 + w2);
            bf16_t* op = attn + rowq * DM + cur.hj * 64 + 4 * fq;
#pragma unroll
            for (int dt = 0; dt < 4; ++dt) { const u32x2 a = pa[dt], b = pb[dt];
                const float r0 = (o[dt][0] * e0 + w1 * pg8::bf_lo(a.x) + w2 * pg8::bf_lo(b.x)) * invW, r1 = (o[dt][1] * e0 + w1 * pg8::bf_hi(a.x) + w2 * pg8::bf_hi(b.x)) * invW;
                const float r2 = (o[dt][2] * e0 + w1 * pg8::bf_lo(a.y) + w2 * pg8::bf_lo(b.y)) * invW, r3 = (o[dt][3] * e0 + w1 * pg8::bf_hi(a.y) + w2 * pg8::bf_hi(b.y)) * invW;
                u32x2 w; w.x = cvt_pk_bf16(r0, r1); w.y = cvt_pk_bf16(r2, r3); *(u32x2*)(op + 16 * dt) = w; }
        }
        if (!hn) break;
        uid = nuid; attn_decode(uid, COMBINE, S, cur); buf ^= 1;
    }
#undef ATT_STAGE
    asm volatile("s_waitcnt vmcnt(0)" ::: "memory");
    __syncthreads();
}

__device__ __forceinline__ void sgu_phase(LAS unsigned char* lds, const bf16_t* uv, const float* rowsq, const float* w_s, const float* b_s, const float* g_sgu, bf16_t* sgu,
                                          int vcu, int G, int tid, int lane, int wave) {
    const int nunits = 2048; const int fr = lane & 15, fq = lane >> 4;
    LAS float* rsl = (LAS float*)(lds + 32768);
    u32x4 vreg[4];
    int uid = vcu; if (uid >= nunits) return;
#define SGU_PREFETCH(UID) do { const int cgp_ = (UID) & 7, pc_ = (UID) >> 3; _Pragma("unroll") for (int i = 0; i < 4; ++i) { const int idx = tid + 512 * i, row = idx >> 4, ch = idx & 15; \
        vreg[i] = *(const u32x4*)(uv + (size_t)(pc_ * 128 + row) * UV_W + 1024 + cgp_ * 128 + ch * 8); } } while (0)
    SGU_PREFETCH(uid);
    for (;;) {
        const int cgp = uid & 7, pc = uid >> 3;
        __syncthreads();
#pragma unroll
        for (int i = 0; i < 4; ++i) { const int idx = tid + 512 * i, row = idx >> 4, ch = idx & 15;
            *(LAS u32x4*)(lds + 256 * row + 16 * (ch ^ (((row & 3) << 2) | ((row >> 2) & 3)))) = vreg[i]; }
        if (tid < 128) rsl[tid] = __builtin_amdgcn_rsqf(rowsq[pc * 128 + tid] * (1.0f / DM) + EPS);
        __syncthreads();
        const int nuid = uid + G; const bool hn = nuid < nunits;
        if (hn) SGU_PREFETCH(nuid);
        f32x4 acc[8];
#pragma unroll
        for (int ct = 0; ct < 8; ++ct) acc[ct] = (f32x4){0.f, 0.f, 0.f, 0.f};
        const float* wrow = w_s + ((size_t)cgp * 128 + 16 * wave + fr) * 128 + 8 * fq;
        const int q = fr >> 2, p = fr & 3;
#pragma unroll
        for (int ks = 0; ks < 4; ++ks) {
            const f32x4 w0 = *(const f32x4*)(wrow + 32 * ks), w1 = *(const f32x4*)(wrow + 32 * ks + 4);
            const f32x4 r0 = *(const LAS f32x4*)(rsl + 32 * ks + 8 * fq), r1 = *(const LAS f32x4*)(rsl + 32 * ks + 8 * fq + 4);
            const bf16x8 wf = __builtin_bit_cast(bf16x8, pg8::pack8(w0 * r0, w1 * r1));
            const int ra = 32 * ks + 8 * fq + q, rb = ra + 4;
            const int xa = ((ra & 3) << 2) | ((ra >> 2) & 3), xb = ((rb & 3) << 2) | ((rb >> 2) & 3);
#pragma unroll
            for (int ct = 0; ct < 8; ++ct) { const int ch = 2 * ct + (p >> 1);
                const s16x4 a = vtr(lds + 256 * ra + 16 * (ch ^ xa) + 8 * (p & 1)), b = vtr(lds + 256 * rb + 16 * (ch ^ xb) + 8 * (p & 1));
                const bf16x8 vf = __builtin_shufflevector(a, b, 0, 1, 2, 3, 4, 5, 6, 7);
                acc[ct] = __builtin_amdgcn_mfma_f32_16x16x32_bf16(vf, wf, acc[ct], 0, 0, 0); } }
        const int t = 16 * wave + fr; const size_t row = (size_t)pc * 128 + t; const float bt = b_s[cgp * 128 + t];
#pragma unroll
        for (int ct = 0; ct < 8; ++ct) { const int c0 = cgp * 128 + 16 * ct + 4 * fq;
            const f32x4 gv = *(const f32x4*)(g_sgu + c0); const u32x2 uw = *(const u32x2*)(uv + row * UV_W + c0);
            const f32x4 mixed = acc[ct] * gv + bt;
            const f32x4 uu = (f32x4){pg8::bf_lo(uw.x), pg8::bf_hi(uw.x), pg8::bf_lo(uw.y), pg8::bf_hi(uw.y)};
            const f32x4 ov = uu * mixed; u32x2 w; w.x = cvt_pk_bf16(ov[0], ov[1]); w.y = cvt_pk_bf16(ov[2], ov[3]);
            *(u32x2*)(sgu + row * DM + c0) = w; }
        if (!hn) break;
        uid = nuid;
    }
#undef SGU_PREFETCH
    __syncthreads();
}


#define XB_TMO      128
#define XB_XCNT(j)  (256  + 64 * (j))
#define XB_XSUB(j)  (1280 + 64 * (j))
#define XB_XGEN(j)  (2304 + 64 * (j))
#define XB_TOP      3328
#define XB_TOPGEN   3392
#define XCD_BAR_WORDS 3456
#define XB_SPIN_CAP (1u << 22)
__device__ __forceinline__ unsigned xb_ld(unsigned* p)              { return __hip_atomic_load(p, __ATOMIC_RELAXED, __HIP_MEMORY_SCOPE_AGENT); }
__device__ __forceinline__ unsigned xb_add(unsigned* p, unsigned v) { return __hip_atomic_fetch_add(p, v, __ATOMIC_RELAXED, __HIP_MEMORY_SCOPE_AGENT); }
__device__ __forceinline__ unsigned xb_xcc_id() { return (unsigned)__builtin_amdgcn_s_getreg((3 << 11) | 20) & 0xFu; }
#define XB_SPIN(cond, bar) do { unsigned _sp = 0; while (cond) { __builtin_amdgcn_s_sleep(1); \
    if ((++_sp & 255u) == 0u) { if (xb_ld(&(bar)[XB_TMO])) break; if (_sp > XB_SPIN_CAP) { atomicAdd(&(bar)[XB_TMO], 1u); break; } } } } while (0)
struct XcdBarrier { unsigned* bar; unsigned x; volatile LAS unsigned* st; };
__device__ __forceinline__ XcdBarrier xcd_barrier_post(unsigned* bar, volatile LAS unsigned* st) {
    XcdBarrier b; b.bar = bar; b.x = xb_xcc_id(); b.st = st;
    if (threadIdx.x == 0) (void)xb_add(&bar[XB_XCNT(b.x)], 1u);
    return b;
}
__device__ __forceinline__ void xcd_barrier_complete(unsigned* bar, unsigned x, unsigned& nloc, unsigned& nx) {
    const unsigned G = gridDim.x * gridDim.y * gridDim.z;
    unsigned sum, cnt, mine, sp = 0u;
    for (;;) {
        sum = 0u; cnt = 0u; mine = 0u;
#pragma unroll
        for (unsigned j = 0; j < 16; ++j) { const unsigned c = xb_ld(&bar[XB_XCNT(j)]); sum += c; cnt += (c > 0u) ? 1u : 0u; mine = (j == x) ? c : mine; }
        if (sum == G) break;
        __builtin_amdgcn_s_sleep(1);
        if ((++sp & 255u) == 0u) { if (xb_ld(&bar[XB_TMO])) break; if (sp > XB_SPIN_CAP) { atomicAdd(&bar[XB_TMO], 1u); break; } }
    }
    nloc = mine > 0u ? mine : 1u; nx = cnt > 0u ? cnt : 1u;
}
__device__ __forceinline__ void xcd_barrier(const XcdBarrier& b) {
    asm volatile("s_waitcnt vmcnt(0)" ::: "memory");
    __syncthreads();
    if (threadIdx.x == 0) {
        unsigned* bar = b.bar;
        __builtin_amdgcn_s_waitcnt(0);
        unsigned nloc = b.st[0], nx = b.st[1];
        if (nloc == 0u) { xcd_barrier_complete(bar, b.x, nloc, nx); b.st[0] = nloc; b.st[1] = nx; }
        const unsigned old = xb_add(&bar[XB_XSUB(b.x)], 1u);
        const unsigned gen = old / nloc;
        if (old + 1u == (gen + 1u) * nloc) {
            __builtin_amdgcn_fence(__ATOMIC_RELEASE, "agent");
            asm volatile("s_waitcnt vmcnt(0)" ::: "memory");
            const unsigned og = xb_add(&bar[XB_TOP], 1u);
            const unsigned tg = og / nx;
            if (og + 1u == (tg + 1u) * nx) xb_add(&bar[XB_TOPGEN], 1u);
            else XB_SPIN(xb_ld(&bar[XB_TOPGEN]) == tg, bar);
            __builtin_amdgcn_fence(__ATOMIC_ACQUIRE, "agent");
            xb_add(&bar[XB_XGEN(b.x)], 1u);
            asm volatile("s_waitcnt vmcnt(0)" ::: "memory");
        } else {
            XB_SPIN(xb_ld(&bar[XB_XGEN(b.x)]) == gen, bar);
            __builtin_amdgcn_fence(__ATOMIC_ACQUIRE, "agent");
            asm volatile("s_waitcnt vmcnt(0)" ::: "memory");
        }
    }
    __syncthreads();
}

struct Args { const float* in[14]; float* out; unsigned char* ws; int ph_lo, ph_hi; };
constexpr int N_PHASES = 22;

__global__ void __launch_bounds__(512, 2) mega_fwd(Args a) {
    extern __shared__ __attribute__((aligned(16))) unsigned char lds_raw[];
    LAS unsigned char* lds = (LAS unsigned char*)lds_raw;
    cg::grid_group grid = cg::this_grid();
    const int G = gridDim.x, bx = blockIdx.x;
    const int vcu = (G % 8 == 0) ? (bx % 8) * (G / 8) + bx / 8 : bx;
    volatile LAS unsigned* misc = (volatile LAS unsigned*)(lds + LDS_MISC_OFF);
    if (threadIdx.x < 2) misc[threadIdx.x] = 0u;
    __syncthreads();
    const XcdBarrier xbar = xcd_barrier_post((unsigned*)(a.ws + WS_BAR), misc);
    grid.sync();
#define WSP(T, off) ((T*)(ws + (off)))
    for (int ph = a.ph_lo; ph < a.ph_hi; ++ph) {
        if (ph != a.ph_lo) xcd_barrier(xbar);
        size_t zoff = 0; asm volatile("" : "+s"(zoff)); unsigned char* ws = a.ws + zoff;
        int tid = threadIdx.x; asm volatile("" : "+v"(tid));
        const int lane = tid & 63, wave = __builtin_amdgcn_readfirstlane(tid >> 6);
        const int gw = vcu * 8 + wave, ngw = G * 8;
        if (ph == 0) {
            LAS float* scr = (LAS float*)(lds + wave * 16384);
            constexpr int I_IN = (DM / 64) * (IN_COLS / 32), I_A = (AO / 64) * (DM / 32), I_B = (DM / 64) * (DM / 32), I_O = I_B, I_UP = (DM / 64) * (FF / 32), I_DN = (FF / 64) * (DM / 32);
            constexpr int NITEMS = I_IN + I_A + I_B + I_O + I_UP + I_DN;
            for (int it = gw; it < I_IN; it += ngw) p0_transpose_item(a.in[3], DM, IN_COLS, WSP(bf16_t, WS_WIN), a.in[2], scr, it, lane);
            hprep_rows(a.in[0], WSP(bf16_t, WS_H), gw, ngw, lane);
            for (int i = gw * 64 + lane; i < (int)(CTL_BYTES / 16); i += ngw * 64) WSP(f32x4, WS_CTL)[i] = (f32x4){0.f, 0.f, 0.f, 0.f};
            continue;
        }
        const int c = (ph - 1) / 7, k = (ph - 1) % 7;
        const float* xin = (c < 2) ? a.in[0] + (size_t)c * MC * DM : a.in[1];
        float* xout = a.out + (size_t)c * MC * DM;
        const int S = (c < 2) ? 4096 : 8192;
        float* rsqv = WSP(float, OFF_RSQV) + c * MC; float* rsq1 = WSP(float, OFF_RSQ1) + c * MC; float* rsq2 = WSP(float, OFF_RSQ2) + c * MC;
        if (k == 0) {
            pg8::Gemm g{WSP(bf16_t, WS_H), WSP(bf16_t, WS_WIN), MC, IN_COLS, DM}; pg8::StaticOrder So; So.init(MC, IN_COLS, G, bx);
            pg8::EpiProj E{WSP(bf16_t, WS_QKV), WSP(bf16_t, WS_UV), WSP(bf16_t, WS_GG), rsqv};
            pg8::gemm_phase<pg8::EpiProj, pg8::StaticOrder, true, true>(lds, g, So, E);
        } else if (k == 1) {
            if (c == 0) {
                LAS float* scr = (LAS float*)(lds + wave * 16384);
                constexpr int I_A = (AO / 64) * (DM / 32), I_B = (DM / 64) * (DM / 32), I_O = I_B, I_UP = (DM / 64) * (FF / 32), I_DN = (FF / 64) * (DM / 32);
                for (int it = gw; it < I_A + I_B + I_O + I_UP + I_DN; it += ngw) {
                    int r = it;
                    if (r < I_A) { p0_transpose_item(a.in[7], AO, DM, WSP(bf16_t, WS_WA), nullptr, scr, r, lane, DM); continue; } r -= I_A;
                    if (r < I_B) { p0_transpose_item(a.in[8], DM, DM, WSP(bf16_t, WS_WB), nullptr, scr, r, lane); continue; } r -= I_B;
                    if (r < I_O) { p0_transpose_item(a.in[9], DM, DM, WSP(bf16_t, WS_WO), nullptr, scr, r, lane); continue; } r -= I_O;
                    if (r < I_UP) { p0_transpose_item(a.in[11], DM, FF, WSP(bf16_t, WS_WUP), a.in[10], scr, r, lane); continue; } r -= I_UP;
                    p0_transpose_item(a.in[12], FF, DM, WSP(bf16_t, WS_WDN), nullptr, scr, r, lane);
                }
                __syncthreads();
            }
            if (!(EXP_SKIP_MIX & 1)) attn_phase<false>(lds, WSP(bf16_t, WS_QKV), S, WSP(bf16_t, WS_PO), WSP(float, WS_PS), WSP(bf16_t, WS_ATTN), vcu, G, tid, lane, wave);
            if (c + 1 < NCHUNK) { const float* xn = (c + 1 < 2) ? a.in[0] + (size_t)(c + 1) * MC * DM : a.in[1]; hprep_rows(xn, WSP(bf16_t, WS_H), gw, ngw, lane); }
        } else if (k == 2) {
            if (EXP_SKIP_MIX & 1) { for (size_t i = (size_t)gw * 64 + lane; i < (size_t)MC * AO / 8; i += (size_t)ngw * 64) WSP(u32x4, WS_ATTN)[i] = (EXP_SKIP_MIX & 4) ? *(const u32x4*)(WSP(bf16_t, WS_QKV) + (i >> 6) * QKV_W + (i & 63) * 8) : (u32x4){0u, 0u, 0u, 0u}; }
            else attn_phase<true>(lds, WSP(bf16_t, WS_QKV), S, WSP(bf16_t, WS_PO), WSP(float, WS_PS), WSP(bf16_t, WS_ATTN), vcu, G, tid, lane, wave);
            if (EXP_SKIP_MIX & 2) { for (size_t i = (size_t)gw * 64 + lane; i < (size_t)MC * DM / 8; i += (size_t)ngw * 64) WSP(u32x4, WS_SGU)[i] = (EXP_SKIP_MIX & 4) ? *(const u32x4*)(WSP(bf16_t, WS_UV) + (i >> 7) * UV_W + (i & 127) * 8) : (u32x4){0u, 0u, 0u, 0u}; }
            else sgu_phase(lds, WSP(bf16_t, WS_UV), rsqv, a.in[4], a.in[5], a.in[6], WSP(bf16_t, WS_SGU), vcu, G, tid, lane, wave);
        } else if (k == 3 && (EXP_SKIP_MIX & 8)) {
            for (size_t i = (size_t)gw * 64 + lane; i < (size_t)MC * DM / 8; i += (size_t)ngw * 64) WSP(u32x4, WS_MERGED)[i] = *(const u32x4*)(WSP(bf16_t, WS_GG) + (i >> 7) * GG_W + ((i >> 7) & 1) * 1024 + (i & 127) * 8);
        } else if (k == 3) {
            pg8::StaticOrder So; So.init(MC, DM, G, bx);
            pg8::EpiMid Mh{WSP(bf16_t, WS_GG)}; pg8::EpiMerge E{WSP(bf16_t, WS_GG), WSP(bf16_t, WS_MERGED)};
            pg8::gemm_phase_dual<pg8::EpiMid, pg8::EpiMerge, pg8::StaticOrder>(lds, WSP(bf16_t, WS_ATTN), WSP(bf16_t, WS_WA), AO / 64, WSP(bf16_t, WS_SGU), WSP(bf16_t, WS_WB), DM / 64, DM, So, Mh, E);
        } else if (k == 4) {
            pg8::Gemm g{WSP(bf16_t, WS_MERGED), WSP(bf16_t, WS_WO), MC, DM, DM}; pg8::StaticOrder So; So.init(MC, DM, G, bx);
            pg8::EpiRes<true> E{xin, xout, WSP(bf16_t, WS_X1B), rsq1};
            pg8::gemm_phase<pg8::EpiRes<true>, pg8::StaticOrder, true, true>(lds, g, So, E);
        } else if (k == 5) {
            pg8::Gemm g{WSP(bf16_t, WS_X1B), WSP(bf16_t, WS_WUP), MC, FF, DM}; pg8::StaticOrder So; So.init(MC, FF, G, bx);
            pg8::EpiUp E{rsq1, WSP(bf16_t, WS_UP)};
            pg8::gemm_phase<pg8::EpiUp, pg8::StaticOrder, true, true>(lds, g, So, E);
        } else {
            pg8::Gemm g{WSP(bf16_t, WS_UP), WSP(bf16_t, WS_WDN), MC, DM, FF}; pg8::StaticOrder So; So.init(MC, DM, G, bx);
            pg8::EpiFinal E{WSP(bf16_t, WS_X1B), xout, rsq2, WSP(unsigned, OFF_PCNT) + (size_t)c * 128 * 64, a.in[13]};
            pg8::gemm_phase<pg8::EpiFinal, pg8::StaticOrder, true, true>(lds, g, So, E);
        }
    }
}

extern "C" void kernel_launch(void* const* d_in, const int* in_sizes, int n_in, void* d_out, int out_size, void* d_ws, size_t ws_size, hipStream_t stream) {
    static int grid = 0;
    if (grid == 0) {
        if (n_in != 14 || out_size != M_ALL * DM || ws_size < WS_END) { fprintf(stderr, "kernel_launch: unexpected shapes (n_in %d out %d ws %zu); nothing launched\n", n_in, out_size, ws_size); grid = -1; return; }
        int dev = 0, cus = 0, per_cu = 0;
        if (hipGetDevice(&dev) != hipSuccess || hipDeviceGetAttribute(&cus, hipDeviceAttributeMultiprocessorCount, dev) != hipSuccess) { grid = -1; return; }
        if (hipFuncSetAttribute((const void*)mega_fwd, hipFuncAttributeMaxDynamicSharedMemorySize, LDS_BYTES) != hipSuccess) { fprintf(stderr, "kernel_launch: hipFuncSetAttribute failed\n"); grid = -1; return; }
        if (hipOccupancyMaxActiveBlocksPerMultiprocessor(&per_cu, (const void*)mega_fwd, 512, LDS_BYTES) != hipSuccess || per_cu < 1) { fprintf(stderr, "kernel_launch: occupancy query gave %d\n", per_cu); per_cu = 1; }
        (void)hipGetLastError();
        grid = cus * per_cu;
    }
    if (grid < 0) return;
    (void)hipMemsetAsync((char*)d_ws + WS_BAR, 0, BAR_BYTES, stream);
    Args a{};
    for (int i = 0; i < 14; ++i) a.in[i] = (const float*)d_in[i];
    a.out = (float*)d_out; a.ws = (unsigned char*)d_ws;
#if MK_MULTI
    for (int p = 0; p < N_PHASES; ++p) { a.ph_lo = p; a.ph_hi = p + 1; hipLaunchKernelGGL(mega_fwd, dim3(grid), dim3(512), LDS_BYTES, stream, a); }
#else
    a.ph_lo = 0; a.ph_hi = N_PHASES;
    void* args[] = {&a};
    hipError_t e = hipLaunchCooperativeKernel((const void*)mega_fwd, dim3(grid), dim3(512), args, LDS_BYTES, stream);
    if (e != hipSuccess) fprintf(stderr, "cooperative launch failed: %s (grid %d)\n", hipGetErrorString(e), grid);
#endif
}
```
